# Optimizing an MI355X kernel written in HIP

```python
import math
import jax, jax.numpy as jnp
from jax import lax
import numpy as np

D_MODEL = 1024
BATCH = 8
SEQ = 8192
DEPTH = 2
DEC_BATCH = 16
DEC_SEQ = 32
PAST_LEN = 4096

CHUNK = 64
Q_BLOCK = 128
ROPE_THETA = 500000.0
N_A = (DEPTH + 1) // 2
N_C = DEPTH // 2
H_MLA = 8
MLA_NOPE = 64
MLA_ROPE = 32
MLA_V = 64
Q_LORA = 512
KV_LORA = 256
H_FOX = 8
FOX_DH = 64
FORGET_BIAS_LO = 2.0
FORGET_BIAS_HI = 6.0
H_DIFF = 8
DIFF_DH = 64
DIFF_ROT = DIFF_DH // 4
C_W = H_DIFF * 2 * DIFF_DH
D_FF = 4 * D_MODEL
FOX_W = H_FOX * FOX_DH
A_IN = Q_LORA + KV_LORA + MLA_ROPE + 3 * FOX_W + H_FOX
A_OUT = H_MLA * MLA_V + FOX_W

kernel_name = 'chunk_causal_mla_fox_diffattn_step'


def _rms(x, g, eps=1e-6):
    xf = x.astype(jnp.float32)
    y = xf * lax.rsqrt(jnp.mean(xf * xf, axis=-1, keepdims=True) + eps)
    return (y * g.astype(jnp.float32)).astype(x.dtype)


def _rope(x, pos, rot):
    half = rot // 2
    inv = ROPE_THETA ** (-jnp.arange(half, dtype=jnp.float32) / half)
    ang = pos.astype(jnp.float32)[:, None] * inv[None, :]
    cos = jnp.cos(ang)[None, :, None, :]
    sin = jnp.sin(ang)[None, :, None, :]
    xr = x[..., :rot].astype(jnp.float32)
    x1, x2 = xr[..., :half], xr[..., half:]
    r = jnp.concatenate([x1 * cos - x2 * sin, x2 * cos + x1 * sin], axis=-1).astype(x.dtype)
    return jnp.concatenate([r, x[..., rot:]], axis=-1)


def _mask(q_pos, k_pos, frame_causal):
    if frame_causal:
        return k_pos[None, :] <= q_pos[:, None]
    return (k_pos[None, :] // CHUNK) <= (q_pos[:, None] // CHUNK)


def _probs(q, k, q_pos, k_pos, frame_causal, q_cum=None, k_cum=None):
    s = jnp.einsum('bqhd,bkhd->bhqk', q, k, preferred_element_type=jnp.float32) * (q.shape[-1] ** -0.5)
    if q_cum is not None:
        s = s + jnp.swapaxes(q_cum, 1, 2)[..., :, None] - jnp.swapaxes(k_cum, 1, 2)[..., None, :]
    s = jnp.where(_mask(q_pos, k_pos, frame_causal)[None, None], s, -jnp.inf)
    return jax.nn.softmax(s, axis=-1)


def _apply(p, v):
    return jnp.einsum('bhqk,bkhe->bqhe', p, v.astype(jnp.float32)).astype(v.dtype)


def _sweep(fn, q_args, q_pos):
    nb = q_pos.shape[0] // Q_BLOCK

    def split(a):
        return jnp.moveaxis(a.reshape(a.shape[0], nb, Q_BLOCK, *a.shape[2:]), 1, 0)

    xs = tuple(split(a) for a in q_args) + (q_pos.reshape(nb, Q_BLOCK),)
    out = lax.map(lambda blk: fn(*blk), xs)
    out = jnp.moveaxis(out, 0, 1)
    return out.reshape(out.shape[0], nb * Q_BLOCK, *out.shape[3:])


def _a_project(h, pos, w_in, g_q, w_uq, g_kv, b_f):
    B, T, _ = h.shape
    proj = h @ w_in
    o1 = Q_LORA
    o2 = o1 + KV_LORA
    o3 = o2 + MLA_ROPE
    o4 = o3 + FOX_W
    o5 = o4 + FOX_W
    o6 = o5 + FOX_W
    q = (_rms(proj[..., :o1], g_q) @ w_uq).reshape(B, T, H_MLA, MLA_NOPE + MLA_ROPE)
    q = jnp.concatenate([q[..., :MLA_NOPE], _rope(q[..., MLA_NOPE:], pos, MLA_ROPE)], axis=-1)
    ckv = _rms(proj[..., o1:o2], g_kv)
    krope = _rope(proj[..., o2:o3][:, :, None, :], pos, MLA_ROPE)[:, :, 0, :]
    fq = proj[..., o3:o4].reshape(B, T, H_FOX, FOX_DH)
    fk = proj[..., o4:o5].reshape(B, T, H_FOX, FOX_DH)
    fv = proj[..., o5:o6].reshape(B, T, H_FOX, FOX_DH)
    logf = jax.nn.log_sigmoid((proj[..., o6:] + b_f).astype(jnp.float32))
    return q, fq, (ckv, krope, fk, fv, logf)


def _a_attend(qm, fq, cum_q, q_pos, km, vm, fk, fv, cum_k, k_pos):
    B, Tq = qm.shape[:2]
    om = _apply(_probs(qm, km, q_pos, k_pos, False), vm)
    of = _apply(_probs(fq, fk, q_pos, k_pos, True, cum_q, cum_k), fv)
    return jnp.concatenate([om.reshape(B, Tq, -1), of.reshape(B, Tq, -1)], axis=-1)


def _mixer_a(h, q_pos, past, w_in, g_q, w_uq, g_kv, w_ukv, b_f, w_out):
    T = h.shape[1]
    qm, fq, new = _a_project(h, q_pos, w_in, g_q, w_uq, g_kv, b_f)
    rows = new if past is None else tuple(
        jnp.concatenate([p.astype(n.dtype), n], axis=1) for p, n in zip(past, new))
    ckv, krope, fk, fv, logf = rows
    B, L = ckv.shape[:2]
    k_pos = jnp.arange(L)
    kv = (ckv @ w_ukv).reshape(B, L, H_MLA, MLA_NOPE + MLA_V)
    km = jnp.concatenate(
        [kv[..., :MLA_NOPE], jnp.broadcast_to(krope[:, :, None, :], (B, L, H_MLA, MLA_ROPE))], axis=-1)
    vm = kv[..., MLA_NOPE:]
    cum = jnp.cumsum(logf.astype(jnp.float32), axis=1)
    cum_q = cum[:, L - T:]
    attend = lambda a, b, c, p: _a_attend(a, b, c, p, km, vm, fk, fv, cum, k_pos)
    if past is None:
        o = _sweep(attend, (qm, fq, cum_q), q_pos)
    else:
        o = attend(qm, fq, cum_q, q_pos)
    return o @ w_out, new


def _c_project(h, pos, w_in):
    B, T, _ = h.shape
    proj = h @ w_in

    def heads(a):
        a = a.reshape(B, T, 2 * H_DIFF, DIFF_DH)
        return _rope(a, pos, DIFF_ROT).reshape(B, T, H_DIFF, 2 * DIFF_DH)

    q = heads(proj[..., :C_W])
    k = heads(proj[..., C_W:2 * C_W])
    v = proj[..., 2 * C_W:].reshape(B, T, H_DIFF, 2 * DIFF_DH)
    return q, k, v


def _c_attend(q, q_pos, k, v, k_pos, lam, g_sub, lam_init):
    B, Tq = q.shape[:2]
    p1 = _probs(q[..., :DIFF_DH], k[..., :DIFF_DH], q_pos, k_pos, False)
    p2 = _probs(q[..., DIFF_DH:], k[..., DIFF_DH:], q_pos, k_pos, False)
    o = jnp.einsum('bhqk,bkhe->bqhe', p1 - lam * p2, v.astype(jnp.float32))
    o = _rms(o, g_sub, 1e-5) * (1.0 - lam_init)
    return o.reshape(B, Tq, C_W).astype(v.dtype)


def _mixer_c(h, q_pos, past, w_in, lam_p, g_sub, w_out, lam_init):
    q, k, v = _c_project(h, q_pos, w_in)
    new = (k, v)
    rows = new if past is None else tuple(
        jnp.concatenate([p.astype(n.dtype), n], axis=1) for p, n in zip(past, new))
    ka, va = rows
    k_pos = jnp.arange(ka.shape[1])
    lp = lam_p.astype(jnp.float32)
    lam = jnp.exp(jnp.sum(lp[0] * lp[1])) - jnp.exp(jnp.sum(lp[2] * lp[3])) + lam_init
    attend = lambda a, p: _c_attend(a, p, ka, va, k_pos, lam, g_sub, lam_init)
    if past is None:
        o = _sweep(attend, (q,), q_pos)
    else:
        o = attend(q, q_pos)
    return o @ w_out, new


def _mlp(h, w_up, w_down):
    return jnp.square(jax.nn.relu(h @ w_up)) @ w_down


def _stack(rows, j):
    return jnp.stack([r[j] for r in rows])


def setup_inputs(seed: int = 0) -> dict:
    key = jax.random.key(seed)
    ks = iter(jax.random.split(key, 40))

    def nrm(shape, scale=1.0):
        return jax.random.normal(next(ks), shape, jnp.float32) * scale

    def gain(shape):
        return 1.0 + nrm(shape, 0.01)

    forget_bias = jnp.linspace(FORGET_BIAS_LO, FORGET_BIAS_HI, H_FOX, dtype=jnp.float32)
    return {
        'x_prompt': nrm((BATCH, SEQ, D_MODEL)),
        'x_sample': nrm((DEC_BATCH, DEC_SEQ, D_MODEL)),
        'cache_mla_ckv': nrm((N_A, DEC_BATCH, PAST_LEN, KV_LORA)),
        'cache_mla_krope': nrm((N_A, DEC_BATCH, PAST_LEN, MLA_ROPE)),
        'cache_fox_k': nrm((N_A, DEC_BATCH, PAST_LEN, H_FOX, FOX_DH)),
        'cache_fox_v': nrm((N_A, DEC_BATCH, PAST_LEN, H_FOX, FOX_DH)),
        'cache_fox_logf': jax.nn.log_sigmoid(nrm((N_A, DEC_BATCH, PAST_LEN, H_FOX)) + forget_bias),
        'cache_diff_k': nrm((N_C, DEC_BATCH, PAST_LEN, H_DIFF, 2 * DIFF_DH)),
        'cache_diff_v': nrm((N_C, DEC_BATCH, PAST_LEN, H_DIFF, 2 * DIFF_DH)),
        'g_mix': gain((DEPTH, D_MODEL)),
        'a_w_in': nrm((N_A, D_MODEL, A_IN), D_MODEL ** -0.5),
        'a_g_q': gain((N_A, Q_LORA)),
        'a_w_uq': nrm((N_A, Q_LORA, H_MLA * (MLA_NOPE + MLA_ROPE)), Q_LORA ** -0.5),
        'a_g_kv': gain((N_A, KV_LORA)),
        'a_w_ukv': nrm((N_A, KV_LORA, H_MLA * (MLA_NOPE + MLA_V)), KV_LORA ** -0.5),
        'a_b_f': forget_bias[None, :] + nrm((N_A, H_FOX), 0.1),
        'a_w_out': nrm((N_A, A_OUT, D_MODEL), A_OUT ** -0.5),
        'c_w_in': nrm((N_C, D_MODEL, 3 * C_W), D_MODEL ** -0.5),
        'c_lam': nrm((N_C, 4, DIFF_DH), 0.1),
        'c_g_sub': gain((N_C, 2 * DIFF_DH)),
        'c_w_out': nrm((N_C, C_W, D_MODEL), C_W ** -0.5),
        'g_mlp': gain((DEPTH, D_MODEL)),
        'w_up': nrm((DEPTH, D_MODEL, D_FF), D_MODEL ** -0.5),
        'w_down': nrm((DEPTH, D_FF, D_MODEL), D_FF ** -0.5),
        'g_final': gain((D_MODEL,)),
    }


def reference(x_prompt, x_sample, cache_mla_ckv, cache_mla_krope, cache_fox_k, cache_fox_v,
              cache_fox_logf, cache_diff_k, cache_diff_v, g_mix, a_w_in, a_g_q, a_w_uq, a_g_kv,
              a_w_ukv, a_b_f, a_w_out, c_w_in, c_lam, c_g_sub, c_w_out, g_mlp, w_up, w_down,
              g_final):
    past_len = cache_mla_ckv.shape[2]
    pos_p = jnp.arange(x_prompt.shape[1])
    pos_s = past_len + jnp.arange(x_sample.shape[1])
    xp, xs = x_prompt, x_sample
    a_p, a_s, c_p, c_s = [], [], [], []
    for layer in range(DEPTH):
        i = layer // 2
        hp = _rms(xp, g_mix[layer])
        hs = _rms(xs, g_mix[layer])
        if layer % 2 == 0:
            wa = (a_w_in[i], a_g_q[i], a_w_uq[i], a_g_kv[i], a_w_ukv[i], a_b_f[i], a_w_out[i])
            past = (cache_mla_ckv[i], cache_mla_krope[i], cache_fox_k[i], cache_fox_v[i], cache_fox_logf[i])
            mp, rp = _mixer_a(hp, pos_p, None, *wa)
            ms, rs = _mixer_a(hs, pos_s, past, *wa)
            a_p.append(rp)
            a_s.append(rs)
        else:
            lam_init = 0.8 - 0.6 * math.exp(-0.3 * layer)
            wc = (c_w_in[i], c_lam[i], c_g_sub[i], c_w_out[i], lam_init)
            past = (cache_diff_k[i], cache_diff_v[i])
            mp, rp = _mixer_c(hp, pos_p, None, *wc)
            ms, rs = _mixer_c(hs, pos_s, past, *wc)
            c_p.append(rp)
            c_s.append(rs)
        xp = xp + mp
        xs = xs + ms
        xp = xp + _mlp(_rms(xp, g_mlp[layer]), w_up[layer], w_down[layer])
        xs = xs + _mlp(_rms(xs, g_mlp[layer]), w_up[layer], w_down[layer])
    y_prompt = _rms(xp, g_final)
    y_sample = _rms(xs, g_final)
    return (y_prompt, y_sample,
            _stack(a_p, 0), _stack(a_p, 1), _stack(a_p, 2), _stack(a_p, 3), _stack(a_p, 4),
            _stack(c_p, 0), _stack(c_p, 1),
            _stack(a_s, 0), _stack(a_s, 1), _stack(a_s, 2), _stack(a_s, 3), _stack(a_s, 4),
            _stack(c_s, 0), _stack(c_s, 1))
```

```cpp
#include <hip/hip_runtime.h>
#include <hip/hip_bf16.h>
#include <cstdio>
#include <cstdint>

constexpr int DM = 1024, NBP = 8, SEQ = 8192, NBS = 16, DSEQ = 32, PAST = 4096, KVL = PAST + DSEQ;
constexpr int MP = NBP * SEQ, MS = NBS * DSEQ, MT = MP + MS;
constexpr int MKV = MP + NBS * KVL;
constexpr int A_IN = 2344, NA = 2560, QLORA = 512, KVLORA = 256, NQM = 768, NKV = 1024, DFF = 4096, NC = 3072;
constexpr float C2M = 0.14724444602590306f;
constexpr float C2F = 0.18033688011112042f;
constexpr float LOG2E = 1.4426950408889634f;
constexpr float LAM_INIT = 0.35550906759096934f, ONE_M_LAM_INIT = 0.6444909324090307f;
constexpr int NSPLIT = 16;

constexpr size_t O_Y = 0;
constexpr size_t O_CKV_P = 67633152, O_KROPE_P = 84410368, O_FK_P = 86507520, O_FV_P = 120061952, O_LOGF_P = 153616384;
constexpr size_t O_DK_P = 154140672, O_DV_P = 221249536;
constexpr size_t O_CKV_S = 288358400, O_KROPE_S = 288489472, O_FK_S = 288505856, O_FV_S = 288768000, O_LOGF_S = 289030144;
constexpr size_t O_DK_S = 289034240, O_DV_S = 289558528, O_END = 290082816;

constexpr size_t al256(size_t x) { return (x + 255) / 256 * 256; }
constexpr size_t WS_CTL = 0, CTL_BYTES = 1u << 20;
constexpr size_t WS_TAB16 = WS_CTL + CTL_BYTES;
constexpr size_t WS_TAB8 = WS_TAB16 + (size_t)8192 * 32 * 4;
constexpr size_t WS_WAIN = WS_TAB8 + (size_t)8192 * 16 * 4;
constexpr size_t WS_WUQ = WS_WAIN + (size_t)NA * DM * 2;
constexpr size_t WS_WUKV = WS_WUQ + (size_t)NQM * QLORA * 2;
constexpr size_t WS_WAOUT = WS_WUKV + (size_t)NKV * KVLORA * 2;
constexpr size_t WS_WUP = WS_WAOUT + (size_t)DM * DM * 2;
constexpr size_t WS_WDN = WS_WUP + (size_t)2 * DFF * DM * 2;
constexpr size_t WS_WCIN = WS_WDN + (size_t)2 * DM * DFF * 2;
constexpr size_t WS_WCOUT = WS_WCIN + (size_t)NC * DM * 2;
constexpr size_t WS_XB = WS_WCOUT + (size_t)DM * DM * 2;
constexpr size_t WS_SSQ = WS_XB + (size_t)MT * DM * 2;
constexpr size_t WS_R = al256(WS_SSQ + (size_t)MT * 16 * 4);
constexpr size_t R_QLAT = 0;
constexpr size_t R_QSSQ = R_QLAT + (size_t)MT * QLORA * 2;
constexpr size_t R_CKVB = R_QSSQ + (size_t)MT * 8 * 4;
constexpr size_t R_KRB = R_CKVB + (size_t)MKV * KVLORA * 2;
constexpr size_t R_FQ = R_KRB + (size_t)MKV * 32 * 2;
constexpr size_t R_FK = R_FQ + (size_t)MT * 512 * 2;
constexpr size_t R_FV = R_FK + (size_t)MP * 512 * 2;
constexpr size_t R_CUMP = R_FV + (size_t)MP * 512 * 2;
constexpr size_t R_CUMS = R_CUMP + (size_t)64 * SEQ * 4;
constexpr size_t R_QM = al256(R_CUMS + (size_t)128 * KVL * 4);
constexpr size_t R_KV = R_QM + (size_t)MT * NQM * 2;
constexpr size_t R_O = R_KV + (size_t)MKV * NKV * 2;
constexpr size_t R_PARTM = R_O + (size_t)MT * DM * 2;
constexpr size_t R_PARTF = R_PARTM + (size_t)2048 * 32 * 66 * 4;
constexpr size_t R_END0 = R_PARTF + (size_t)2048 * 32 * 66 * 4;
constexpr size_t R_QC = 0;
constexpr size_t R_KC = R_QC + (size_t)MT * DM * 2;
constexpr size_t R_VC = R_KC + (size_t)MP * DM * 2;
constexpr size_t R_PARTD = R_O + (size_t)MT * DM * 2;
constexpr size_t R_S1 = R_PARTD + (size_t)4096 * 32 * 130 * 4;
constexpr size_t R_END1 = R_S1 + (size_t)256 * 8 * 64 * 64 * 4;
constexpr size_t R_U = 0;
constexpr size_t R_ENDU = (size_t)MT * DFF * 2;
constexpr size_t R_SIZE = R_END0 > R_END1 ? (R_END0 > R_ENDU ? R_END0 : R_ENDU) : (R_END1 > R_ENDU ? R_END1 : R_ENDU);
constexpr size_t WS_END = WS_R + R_SIZE;
static_assert(R_VC + (size_t)MP * DM * 2 <= R_O && R_KC == R_QC + (size_t)MT * DM * 2 && R_VC == R_KC + (size_t)MP * DM * 2, "layer-1 q | k | v consecutive, below O");
static_assert(WS_END <= (size_t)1200 * 1024 * 1024, "d_ws budget");

constexpr int CW_TMO = 0, CW_CODE = 1, CW_BAR = 4096;

constexpr int RING_OFF = 0, RING_BYTES = 131072;
constexpr int EX_OFF = RING_BYTES;
constexpr int SAMP_SCR_OFF = EX_OFF + 4096;
constexpr int LDSCTL_OFF = SAMP_SCR_OFF + 2048;
constexpr int LDS_BYTES = 147456;
static_assert(LDSCTL_OFF + 256 <= LDS_BYTES, "LDS map");

__device__ const float ROPE16_HI[16] = {1.591549367e-01f, 7.008652389e-02f, 3.086376376e-02f, 1.359137055e-02f, 5.985185504e-03f, 2.635675715e-03f, 1.160663669e-03f, 5.111175124e-04f,
                                        2.250790858e-04f, 9.911730012e-05f, 4.364795313e-05f, 1.922110096e-05f, 8.464330676e-06f, 3.727408739e-06f, 1.641426365e-06f, 7.228293271e-07f};
__device__ const float ROPE16_LO[16] = {6.420638243e-09f, -3.367168766e-09f, -6.060805191e-10f, 3.539428195e-10f, 1.724232701e-10f, 1.458525488e-11f, -4.802871642e-11f, -2.710419215e-11f,
                                        -6.753226017e-12f, 2.390691378e-12f, 1.677238209e-12f, -6.428835329e-13f, 4.522939098e-13f, -1.846790678e-14f, 2.120927809e-14f, -2.060453045e-14f};
__device__ const float ROPE8_HI[8] = {1.591549367e-01f, 3.086376376e-02f, 5.985185504e-03f, 1.160663669e-03f, 2.250790858e-04f, 4.364795313e-05f, 8.464330676e-06f, 1.641426365e-06f};
__device__ const float ROPE8_LO[8] = {6.420638243e-09f, -6.060805191e-10f, 1.724232701e-10f, -4.802871642e-11f, -6.753226017e-12f, 1.677238209e-12f, 4.522939098e-13f, 2.120927809e-14f};

namespace pg8 {
#define PG8_LAS __attribute__((address_space(3)))
typedef unsigned short bf16_t;
typedef short bf16x8 __attribute__((ext_vector_type(8)));
typedef float f32x4 __attribute__((ext_vector_type(4)));
typedef unsigned u32x4 __attribute__((ext_vector_type(4)));
constexpr int BM = 256, BK = 64, HALF = 128, HTB = HALF * BK * 2  , STAGE_BYTES = 8 * HTB, NXCD = 8, WGM = 8;

__host__ __device__ __forceinline__ int lds_byte(int r, int c) { const int st = (r >> 4) * 2 + (c >> 5), rr = r & 15, cc = c & 31, ob = rr * 64 + cc * 2; return st * 1024 + (ob ^ (((ob >> 9) & 1) << 5)); }
__host__ __device__ __forceinline__ void stage_rc(int b, int& R, int& C) { const int st = b / 1024, sb = b % 1024, swz = sb ^ (((sb >> 9) & 1) << 5); R = (st >> 1) * 16 + swz / 64; C = (st & 1) * 32 + (swz % 64) / 2; }
__host__ __device__ __forceinline__ int perm32(int rho) { const int n = rho >> 4, i = rho & 15; return 8 * (i >> 2) + 4 * n + (i & 3); }

struct Unit { int pm, pn; };
struct Gemm { const bf16_t* A; const bf16_t* Bt; int M, N, K; };

struct StaticOrder {
    int nM, nN, nwg, G, c;
    __host__ __device__ void init(int M, int N, int G_, int c_) { nM = M / BM; nN = N / BM; nwg = nM * nN; G = G_; c = c_; }
    __host__ __device__ bool next(int i, Unit& u) const {
        const long L = (long)i * G + c; if (L >= nwg) return false;
        int wgid = (int)L; { const int q = nwg / NXCD, r = nwg % NXCD, xcd = wgid % NXCD, off = wgid / NXCD; wgid = (xcd < r ? xcd * (q + 1) : r * (q + 1) + (xcd - r) * q) + off; }
        const int nig = WGM * nN, gid = wgid / nig, fm = gid * WGM, gsz = (nM - fm) < WGM ? (nM - fm) : WGM;
        u.pm = fm + ((wgid % nig) % gsz); u.pn = (wgid % nig) / gsz; return true;
    }
    __device__ __forceinline__ void a_ready(const Unit&) const {}
    __device__ __forceinline__ void done(const Unit&) const {}
};

__device__ __forceinline__ unsigned cvt_pk_bf16(float lo, float hi) { unsigned r; asm volatile("v_cvt_pk_bf16_f32 %0, %1, %2" : "=v"(r) : "v"(lo), "v"(hi)); return r; }
typedef float f32x2 __attribute__((ext_vector_type(2)));
typedef unsigned u32x2 __attribute__((ext_vector_type(2)));
__device__ __forceinline__ u32x2 pk4(f32x4 v) { u32x2 w; w.x = cvt_pk_bf16(v[0], v[1]); w.y = cvt_pk_bf16(v[2], v[3]); return w; }
__device__ __forceinline__ float dot4(f32x4 v) { return (v[0] * v[0] + v[1] * v[1]) + (v[2] * v[2] + v[3] * v[3]); }
__device__ __forceinline__ float row_rstd16(const float* ssq, int row, int fq) {
    const f32x4 v = *(const f32x4*)(ssq + (size_t)row * 16 + 4 * fq);
    float s = (v[0] + v[1]) + (v[2] + v[3]);
    s += __shfl_xor(s, 16); s += __shfl_xor(s, 32);
    return rsqrtf(s * (1.0f / 1024.0f) + 1e-6f);
}
__device__ __forceinline__ float log_sigmoid_f(float z) {
    const float e = __expf(-fabsf(z));
    const float l1p = (e < 1e-3f) ? e * (1.f - 0.5f * e + e * e * (1.f / 3.f)) : __logf(1.f + e);
    return fminf(z, 0.f) - l1p;
}

struct EpiRes {
    static constexpr bool PERM = false, AFTER_DRAIN = false;
    const float* basep; const float* bases;
    float* X; bf16_t* XB; float* ssq;
    __device__ __forceinline__ void operator()(const f32x4 (&acc)[2][2][4][2], const Unit& u, int wr, int wc, int fr, int fq) const {
        const int row0 = u.pm * BM + wr * 64 + fr, col0 = u.pn * BM + wc * 32 + 4 * fq;
        const float* bb = (u.pm >= 256) ? (bases - (size_t)MP * DM) : basep;
#pragma unroll
        for (int ai = 0; ai < 2; ++ai)
#pragma unroll
            for (int m = 0; m < 4; ++m) {
                const int row = row0 + ai * HALF + m * 16; const size_t off = (size_t)row * DM + col0; float ss = 0.f;
#pragma unroll
                for (int bj = 0; bj < 2; ++bj)
#pragma unroll
                    for (int n = 0; n < 2; ++n) {
                        const f32x4 x = *(const f32x4*)(bb + off + bj * HALF + n * 16) + acc[ai][bj][m][n];
                        *(f32x4*)(X + off + bj * HALF + n * 16) = x; *(u32x2*)(XB + off + bj * HALF + n * 16) = pk4(x); ss += dot4(x); }
                ss += __shfl_xor(ss, 16); ss += __shfl_xor(ss, 32);
                if (fq == 0) ssq[(size_t)row * 16 + u.pn * 4 + wc] = ss;
            }
    }
};

struct EpiUp {
    static constexpr bool PERM = true, AFTER_DRAIN = false;
    bf16_t* U; const float* ssq;
    __device__ __forceinline__ void operator()(const f32x4 (&acc)[2][2][4][2], const Unit& u, int wr, int wc, int fr, int fq) const {
        const int row0 = u.pm * BM + wr * 64 + fr, col0 = u.pn * BM + wc * 32 + 8 * fq;
#pragma unroll
        for (int ai = 0; ai < 2; ++ai)
#pragma unroll
            for (int m = 0; m < 4; ++m) {
                const int row = row0 + ai * HALF + m * 16; const float rs = row_rstd16(ssq, row, fq);
                bf16_t* rowp = U + (size_t)row * DFF + col0;
#pragma unroll
                for (int bj = 0; bj < 2; ++bj) {
                    f32x4 v0 = acc[ai][bj][m][0] * rs, v1 = acc[ai][bj][m][1] * rs;
#pragma unroll
                    for (int j = 0; j < 4; ++j) { const float a = fmaxf(v0[j], 0.f), b = fmaxf(v1[j], 0.f); v0[j] = a * a; v1[j] = b * b; }
                    u32x4 w; w.x = cvt_pk_bf16(v0[0], v0[1]); w.y = cvt_pk_bf16(v0[2], v0[3]); w.z = cvt_pk_bf16(v1[0], v1[1]); w.w = cvt_pk_bf16(v1[2], v1[3]);
                    *(u32x4*)(rowp + bj * HALF) = w; }
            }
    }
};

struct EpiKv {
    static constexpr bool PERM = true, AFTER_DRAIN = false;
    bf16_t* O; int ldc;
    __device__ __forceinline__ void operator()(const f32x4 (&acc)[2][2][4][2], const Unit& u, int wr, int wc, int fr, int fq) const {
        const int row0 = u.pm * BM + wr * 64 + fr, col0 = u.pn * BM + wc * 32 + 8 * fq;
#pragma unroll
        for (int ai = 0; ai < 2; ++ai)
#pragma unroll
            for (int m = 0; m < 4; ++m) { bf16_t* rowp = O + (size_t)(row0 + ai * HALF + m * 16) * ldc + col0;
#pragma unroll
                for (int bj = 0; bj < 2; ++bj) { const f32x4 v0 = acc[ai][bj][m][0], v1 = acc[ai][bj][m][1];
                    u32x4 w; w.x = cvt_pk_bf16(v0[0], v0[1]); w.y = cvt_pk_bf16(v0[2], v0[3]); w.z = cvt_pk_bf16(v1[0], v1[1]); w.w = cvt_pk_bf16(v1[2], v1[3]);
                    *(u32x4*)(rowp + bj * HALF) = w; } }
    }
};

struct EpiQup {
    static constexpr bool PERM = false, AFTER_DRAIN = false;
    bf16_t* QM; const float* qssq; const float* tab16;
    __device__ __forceinline__ void operator()(const f32x4 (&acc)[2][2][4][2], const Unit& u, int wr, int wc, int fr, int fq) const {
        const int row0 = u.pm * BM + wr * 64 + fr, col0 = u.pn * BM + wc * 32 + 4 * fq;
#pragma unroll
        for (int ai = 0; ai < 2; ++ai)
#pragma unroll
            for (int m = 0; m < 4; ++m) {
                const int row = row0 + ai * HALF + m * 16;
                const f32x4 s0 = *(const f32x4*)(qssq + (size_t)row * 8), s1 = *(const f32x4*)(qssq + (size_t)row * 8 + 4);
                const float ssum = ((s0[0] + s0[1]) + (s0[2] + s0[3])) + ((s1[0] + s1[1]) + (s1[2] + s1[3]));
                const float rs = rsqrtf(ssum * (1.0f / 512.0f) + 1e-6f) * C2M;
                const int pos = (row >= MP) ? (PAST + ((row - MP) & 31)) : (row & (SEQ - 1));
                const f32x4 cs = *(const f32x4*)(tab16 + (size_t)pos * 32 + 4 * fq), sn = *(const f32x4*)(tab16 + (size_t)pos * 32 + 16 + 4 * fq);
                bf16_t* rowp = QM + (size_t)row * NQM + col0;
#pragma unroll
                for (int bj = 0; bj < 2; ++bj) {
                    const int g = u.pn * 8 + bj * 4 + wc;
                    f32x4 x1 = acc[ai][bj][m][0] * rs, x2 = acc[ai][bj][m][1] * rs;
                    if (g % 3 == 2) { const f32x4 r1 = x1 * cs - x2 * sn, r2 = x2 * cs + x1 * sn; x1 = r1; x2 = r2; }
                    *(u32x2*)(rowp + bj * HALF) = pk4(x1); *(u32x2*)(rowp + bj * HALF + 16) = pk4(x2); }
            }
    }
};

struct EpiAin {
    static constexpr bool PERM = false, AFTER_DRAIN = false;
    const float* ssq; bf16_t* QLAT; float* QSSQ; bf16_t* CKVB; bf16_t* KRB; bf16_t* FQ; bf16_t* FK; bf16_t* FV;
    float* out;
    const float* g_kv; const float* b_f; const float* tab16;
    PG8_LAS float* ex; PG8_LAS unsigned* excnt;
    __device__ __forceinline__ void operator()(const f32x4 (&acc)[2][2][4][2], const Unit& u, int wr, int wc, int fr, int fq) const {
        const int row0 = u.pm * BM + wr * 64 + fr, cl0 = wc * 32 + 4 * fq;
        const bool samp = u.pm >= 256;
        const int pn = u.pn;
#define RSV(ai, m) row_rstd16(ssq, row0 + (ai) * HALF + (m) * 16, fq)
        if (pn < 2) {
#pragma unroll
            for (int ai = 0; ai < 2; ++ai)
#pragma unroll
                for (int m = 0; m < 4; ++m) { const int row = row0 + ai * HALF + m * 16; float ss = 0.f; bf16_t* rowp = QLAT + (size_t)row * QLORA + pn * 256 + cl0; const float rsv = RSV(ai, m);
#pragma unroll
                    for (int bj = 0; bj < 2; ++bj)
#pragma unroll
                        for (int n = 0; n < 2; ++n) { const f32x4 v = acc[ai][bj][m][n] * rsv; ss += dot4(v); *(u32x2*)(rowp + bj * HALF + n * 16) = pk4(v); }
                    ss += __shfl_xor(ss, 16); ss += __shfl_xor(ss, 32);
                    if (fq == 0) QSSQ[(size_t)row * 8 + pn * 4 + wc] = ss; }
        } else if (pn == 2) {
            PG8_LAS float* exh = ex + wr * 512;
#pragma unroll
            for (int ai = 0; ai < 2; ++ai)
#pragma unroll
                for (int m = 0; m < 4; ++m) { float ss = 0.f; const float rsv = RSV(ai, m);
#pragma unroll
                    for (int bj = 0; bj < 2; ++bj)
#pragma unroll
                        for (int n = 0; n < 2; ++n) { const f32x4 v = acc[ai][bj][m][n] * rsv; ss += dot4(v); }
                    ss += __shfl_xor(ss, 16); ss += __shfl_xor(ss, 32);
                    if (fq == 0) exh[(ai * 64 + m * 16 + fr) * 4 + wc] = ss; }
            asm volatile("s_waitcnt lgkmcnt(0)" ::: "memory");
            unsigned old = 0u;
            if (fr == 0 && fq == 0) old = __hip_atomic_fetch_add(excnt + wr, 1u, __ATOMIC_RELAXED, __HIP_MEMORY_SCOPE_WORKGROUP);
            const unsigned target = ((unsigned)__builtin_amdgcn_readfirstlane((int)old) / 4u + 1u) * 4u;
            { unsigned sp = 0; while (__hip_atomic_load(excnt + wr, __ATOMIC_RELAXED, __HIP_MEMORY_SCOPE_WORKGROUP) < target) { __builtin_amdgcn_s_sleep(1); if (++sp > (1u << 22)) break; } }
            asm volatile("s_waitcnt lgkmcnt(0)" ::: "memory");
#pragma unroll
            for (int ai = 0; ai < 2; ++ai)
#pragma unroll
                for (int m = 0; m < 4; ++m) { const int row = row0 + ai * HALF + m * 16;
                    const f32x4 t = *(const PG8_LAS f32x4*)(exh + (ai * 64 + m * 16 + fr) * 4);
                    const float rc = rsqrtf(((t[0] + t[1]) + (t[2] + t[3])) * (1.0f / 256.0f) + 1e-6f) * RSV(ai, m);
                    const int srow = row - MP;
                    const size_t orow = samp ? (O_CKV_S + (size_t)srow * 256) : (O_CKV_P + (size_t)row * 256);
                    const size_t brow = samp ? ((size_t)MP + (size_t)(srow >> 5) * KVL + PAST + (srow & 31)) : (size_t)row;
#pragma unroll
                    for (int bj = 0; bj < 2; ++bj)
#pragma unroll
                        for (int n = 0; n < 2; ++n) { const int c = cl0 + bj * HALF + n * 16; const f32x4 v = acc[ai][bj][m][n] * rc * *(const f32x4*)(g_kv + c);
                            *(f32x4*)(out + orow + c) = v; *(u32x2*)(CKVB + brow * KVLORA + c) = pk4(v); } }
        } else if (pn < 5) {
#pragma unroll
            for (int ai = 0; ai < 2; ++ai)
#pragma unroll
                for (int m = 0; m < 4; ++m) { const int row = row0 + ai * HALF + m * 16; bf16_t* rowp = FQ + (size_t)row * 512 + (pn - 3) * 256 + cl0; const float s = RSV(ai, m) * C2F;
#pragma unroll
                    for (int bj = 0; bj < 2; ++bj)
#pragma unroll
                        for (int n = 0; n < 2; ++n) *(u32x2*)(rowp + bj * HALF + n * 16) = pk4(acc[ai][bj][m][n] * s); }
        } else if (pn < 9) {
            const bool isk = pn < 7; const int ct = (isk ? pn - 5 : pn - 7) * 256 + cl0;
            bf16_t* B = isk ? FK : FV;
            const size_t obase = samp ? (isk ? O_FK_S : O_FV_S) : (isk ? O_FK_P : O_FV_P);
#pragma unroll
            for (int ai = 0; ai < 2; ++ai)
#pragma unroll
                for (int m = 0; m < 4; ++m) { const int row = row0 + ai * HALF + m * 16; const int orow = samp ? row - MP : row; const float rsv = RSV(ai, m);
#pragma unroll
                    for (int bj = 0; bj < 2; ++bj)
#pragma unroll
                        for (int n = 0; n < 2; ++n) { const f32x4 v = acc[ai][bj][m][n] * rsv; const int c = ct + bj * HALF + n * 16;
                            *(f32x4*)(out + obase + (size_t)orow * 512 + c) = v; if (!samp) *(u32x2*)(B + (size_t)row * 512 + c) = pk4(v); } }
        } else {
            if (wc == 0) {
#pragma unroll
                for (int ai = 0; ai < 2; ++ai)
#pragma unroll
                    for (int m = 0; m < 4; ++m) { const int row = row0 + ai * HALF + m * 16; const int srow = row - MP;
                        const int pos = samp ? (PAST + (srow & 31)) : (row & (SEQ - 1));
                        const f32x4 cs = *(const f32x4*)(tab16 + (size_t)pos * 32 + 4 * fq), sn = *(const f32x4*)(tab16 + (size_t)pos * 32 + 16 + 4 * fq);
                        const float rsv = RSV(ai, m); const f32x4 x1 = acc[ai][0][m][0] * rsv, x2 = acc[ai][0][m][1] * rsv;
                        const f32x4 r1 = x1 * cs - x2 * sn, r2 = x2 * cs + x1 * sn;
                        const size_t orow = samp ? (O_KROPE_S + (size_t)srow * 32) : (O_KROPE_P + (size_t)row * 32);
                        const size_t brow = samp ? ((size_t)MP + (size_t)(srow >> 5) * KVL + PAST + (srow & 31)) : (size_t)row;
                        *(f32x4*)(out + orow + 4 * fq) = r1; *(f32x4*)(out + orow + 16 + 4 * fq) = r2;
                        *(u32x2*)(KRB + brow * 32 + 4 * fq) = pk4(r1); *(u32x2*)(KRB + brow * 32 + 16 + 4 * fq) = pk4(r2); }
            } else if (wc == 1) {
                const f32x4 bf = *(const f32x4*)(b_f + 4 * (fq & 1));
#pragma unroll
                for (int ai = 0; ai < 2; ++ai)
#pragma unroll
                    for (int m = 0; m < 4; ++m) { const int row = row0 + ai * HALF + m * 16;
                        const float rsv = RSV(ai, m);
                        const f32x4 z = acc[ai][0][m][0] * rsv + bf; f32x4 lf;
#pragma unroll
                        for (int j = 0; j < 4; ++j) lf[j] = log_sigmoid_f(z[j]);
                        const size_t orow = samp ? (O_LOGF_S + (size_t)(row - MP) * 8) : (O_LOGF_P + (size_t)row * 8);
                        if (fq < 2) *(f32x4*)(out + orow + 4 * fq) = lf; }
            }
        }
#undef RSV
    }
};

struct EpiCin {
    static constexpr bool PERM = false, AFTER_DRAIN = false;
    const float* ssq; bf16_t* QC; float* out; const float* tab8;
    __device__ __forceinline__ void operator()(const f32x4 (&acc)[2][2][4][2], const Unit& u, int wr, int wc, int fr, int fq) const {
        const int row0 = u.pm * BM + wr * 64 + fr, cl0 = wc * 32 + 4 * fq;
        const bool samp = u.pm >= 256; const int pn = u.pn; const int kind = pn >> 2;
        const int ct = (pn & 3) * 256 + cl0;
        const bool rot = (kind < 2) && ((wc & 1) == 0);
        const size_t obase = (samp ? O_DK_S : O_DK_P) + (size_t)(kind == 2) * (samp ? (O_DV_S - O_DK_S) : (O_DV_P - O_DK_P));
        bf16_t* B = QC + (size_t)(kind >= 1) * ((size_t)MT * DM) + (size_t)(kind >= 2) * ((size_t)MP * DM);
#pragma unroll
        for (int ai = 0; ai < 2; ++ai)
#pragma unroll
            for (int m = 0; m < 4; ++m) { const int row = row0 + ai * HALF + m * 16; const int srow = row - MP; const int orow = samp ? srow : row;
                const float rsv = row_rstd16(ssq, row, fq);
                const int pos = samp ? (PAST + (srow & 31)) : (row & (SEQ - 1));
                const f32x4 cs = *(const f32x4*)(tab8 + (size_t)pos * 16 + 4 * (fq & 1)), sn = *(const f32x4*)(tab8 + (size_t)pos * 16 + 8 + 4 * (fq & 1));
#pragma unroll
                for (int bj = 0; bj < 2; ++bj)
#pragma unroll
                    for (int n = 0; n < 2; ++n) { f32x4 v = acc[ai][bj][m][n] * rsv; const int c = ct + bj * HALF + n * 16;
                        if (n == 0 && kind < 2) {
                            f32x4 p;
#pragma unroll
                            for (int j = 0; j < 4; ++j) p[j] = __shfl_xor(v[j], 32);
                            if (rot) v = (fq < 2) ? (v * cs - p * sn) : (v * cs + p * sn);
                        }
                        if (kind == 0) v = v * C2F;
                        if (kind != 0) *(f32x4*)(out + obase + (size_t)orow * DM + c) = v;
                        if (kind == 0 || !samp) *(u32x2*)(B + (size_t)row * DM + c) = pk4(v); } }
    }
};
template <class Epi, class Sched, bool ALIGN_EPI = false, bool SP2 = false>
__device__ __forceinline__ void gemm_phase(PG8_LAS unsigned char* lds, const Gemm g, const Sched& S, const Epi& E) {
    const int tid = threadIdx.x, wid = __builtin_amdgcn_readfirstlane(tid >> 6), lane = tid & 63, wr = wid >> 2, wc = wid & 3, fr = lane & 15, fq = lane >> 4;
    const int K = g.K, nt = K / BK;
    unsigned voffA[2], voffB[2];
#pragma unroll
    for (int i = 0; i < 2; ++i) { int R, C; stage_rc(tid * 16 + i * 8192, R, C); const int Rb = Epi::PERM ? ((R & ~31) + perm32(R & 31)) : R;
        voffA[i] = (unsigned)(R * K + C) * 2u; voffB[i] = (unsigned)(Rb * K + C) * 2u; }
    const size_t kstep = (size_t)(BK * 2);
    const size_t hstep = (size_t)HALF * K * 2;
    const size_t tstep = 2 * hstep;
    const unsigned ldsw = (unsigned)wid * 1024u;
    const int aoff = lds_byte(wr * 64 + fr, fq * 8), boff = lds_byte(wc * 32 + fr, fq * 8);
#define PG8_SA(b, h) (((b) * 2 + (h)) * HTB)
#define PG8_SB(b, h) ((4 + (b) * 2 + (h)) * HTB)
#define PG8_STAGE(bufoff, gbase, voff) do { _Pragma("unroll") for (int _i = 0; _i < 2; ++_i) \
        __builtin_amdgcn_global_load_lds((const unsigned*)((const char*)(gbase) + (voff)[_i]), (PG8_LAS unsigned*)(lds + (bufoff) + ldsw + _i * 8192), 16, 0, 0); } while (0)
#define PG8_LDA(dst, b, h) do { _Pragma("unroll") for (int m = 0; m < 4; ++m) _Pragma("unroll") for (int k = 0; k < 2; ++k) dst[m][k] = *(const PG8_LAS bf16x8*)(lds + PG8_SA(b, h) + aoff + m * 2048 + k * 1024); } while (0)
#define PG8_LDB(dst, b, h) do { _Pragma("unroll") for (int n = 0; n < 2; ++n) _Pragma("unroll") for (int k = 0; k < 2; ++k) dst[n][k] = *(const PG8_LAS bf16x8*)(lds + PG8_SB(b, h) + boff + n * 2048 + k * 1024); } while (0)
#define PG8_MMA(ai, bj, At, Bt) do { __builtin_amdgcn_s_setprio(1); _Pragma("unroll") for (int m = 0; m < 4; ++m) _Pragma("unroll") for (int n = 0; n < 2; ++n) _Pragma("unroll") for (int k = 0; k < 2; ++k) \
        acc[ai][bj][m][n] = __builtin_amdgcn_mfma_f32_16x16x32_bf16(Bt[n][k], At[m][k], acc[ai][bj][m][n], 0, 0, 0); __builtin_amdgcn_s_setprio(0); } while (0)
#define PG8_WAIT_V(n) asm volatile("s_waitcnt vmcnt(" #n ")" ::: "memory")
#define PG8_WAIT_L(n) asm volatile("s_waitcnt lgkmcnt(" #n ")" ::: "memory")
#define PG8_BAR __builtin_amdgcn_s_barrier()
#define PG8_SCHED __builtin_amdgcn_sched_barrier(0)
    Unit cur, nxt; int ui = 0;
    if (!S.next(0, cur)) return;
    f32x4 acc[2][2][4][2];
#pragma unroll
    for (int a = 0; a < 2; ++a)
#pragma unroll
        for (int b = 0; b < 2; ++b)
#pragma unroll
            for (int m = 0; m < 4; ++m)
#pragma unroll
                for (int n = 0; n < 2; ++n) acc[a][b][m][n] = (f32x4){0.f, 0.f, 0.f, 0.f};
    bf16x8 At[4][2], B0[2][2], B1[2][2];
    const char* cA = (const char*)g.A + (size_t)cur.pm * tstep; const char* cB = (const char*)g.Bt + (size_t)cur.pn * tstep;
    S.a_ready(cur);
    if constexpr (SP2) {
        PG8_STAGE(PG8_SB(0, 0), cB, voffB); PG8_STAGE(PG8_SB(0, 1), cB + hstep, voffB); PG8_STAGE(PG8_SA(0, 0), cA, voffA); PG8_STAGE(PG8_SA(0, 1), cA + hstep, voffA);
        if (wr == 1) PG8_BAR;
        PG8_WAIT_V(2); PG8_BAR;
        PG8_STAGE(PG8_SB(1, 0), cB + kstep, voffB); PG8_STAGE(PG8_SA(1, 0), cA + kstep, voffA); PG8_STAGE(PG8_SB(1, 1), cB + hstep + kstep, voffB);
        PG8_WAIT_V(6); PG8_BAR;
    } else {
        PG8_STAGE(PG8_SB(0, 0), cB, voffB); PG8_STAGE(PG8_SA(0, 0), cA, voffA); PG8_STAGE(PG8_SB(0, 1), cB + hstep, voffB); PG8_STAGE(PG8_SA(0, 1), cA + hstep, voffA);
        if (wr == 1) PG8_BAR;
        PG8_WAIT_V(4); PG8_BAR;
        PG8_STAGE(PG8_SB(1, 0), cB + kstep, voffB); PG8_STAGE(PG8_SA(1, 0), cA + kstep, voffA); PG8_STAGE(PG8_SB(1, 1), cB + hstep + kstep, voffB);
        PG8_WAIT_V(6); PG8_BAR;
    }
    for (;;) {
        const bool has_next = S.next(ui + 1, nxt);
        const char* nA = has_next ? (const char*)g.A + (size_t)nxt.pm * tstep : cA; const char* nB = has_next ? (const char*)g.Bt + (size_t)nxt.pn * tstep : cB;
        for (int t = 0; t < nt; t += 2) {
            const bool last = (t == nt - 2);
            const char* a1 = cA + (size_t)(t + 1) * kstep;
            const char* a2 = last ? nA : cA + (size_t)(t + 2) * kstep; const char* b2 = last ? nB : cB + (size_t)(t + 2) * kstep;
            const char* a3 = a2 + kstep; const char* b3 = b2 + kstep;
            if (last && has_next) S.a_ready(nxt);
            if constexpr (SP2) {
            PG8_LDB(B0, 0, 0); PG8_LDB(B1, 0, 1); PG8_SCHED; PG8_LDA(At, 0, 0); PG8_STAGE(PG8_SA(1, 1), a1 + hstep, voffA);
            PG8_WAIT_V(8); PG8_WAIT_L(0); PG8_BAR; PG8_MMA(0, 0, At, B0); PG8_MMA(0, 1, At, B1); PG8_BAR; PG8_SCHED;
            PG8_LDA(At, 0, 1); PG8_STAGE(PG8_SB(0, 0), b2, voffB); PG8_STAGE(PG8_SB(0, 1), b2 + hstep, voffB); PG8_STAGE(PG8_SA(0, 0), a2, voffA);
            PG8_WAIT_V(8); PG8_WAIT_L(0); PG8_BAR; PG8_MMA(1, 0, At, B0); PG8_MMA(1, 1, At, B1); PG8_BAR; PG8_SCHED;
            PG8_LDB(B0, 1, 0); PG8_LDB(B1, 1, 1); PG8_SCHED; PG8_LDA(At, 1, 0); PG8_STAGE(PG8_SA(0, 1), a2 + hstep, voffA);
            PG8_WAIT_V(8); PG8_WAIT_L(0); PG8_BAR; PG8_MMA(0, 0, At, B0); PG8_MMA(0, 1, At, B1); PG8_BAR; PG8_SCHED;
            PG8_LDA(At, 1, 1); PG8_STAGE(PG8_SB(1, 0), b3, voffB); PG8_STAGE(PG8_SB(1, 1), b3 + hstep, voffB); PG8_STAGE(PG8_SA(1, 0), a3, voffA);
            PG8_WAIT_V(8); PG8_WAIT_L(0); PG8_BAR; PG8_MMA(1, 0, At, B0); PG8_MMA(1, 1, At, B1); PG8_BAR; PG8_SCHED;
            } else {
            PG8_LDB(B0, 0, 0); PG8_SCHED; PG8_LDA(At, 0, 0); PG8_STAGE(PG8_SA(1, 1), a1 + hstep, voffA);
            PG8_WAIT_L(8); PG8_BAR; PG8_WAIT_L(0); PG8_MMA(0, 0, At, B0); PG8_BAR; PG8_SCHED;
            PG8_LDB(B1, 0, 1); PG8_STAGE(PG8_SB(0, 0), b2, voffB);
            PG8_BAR; PG8_WAIT_L(0); PG8_MMA(0, 1, At, B1); PG8_BAR;
            PG8_LDA(At, 0, 1); PG8_STAGE(PG8_SA(0, 0), a2, voffA);
            PG8_BAR; PG8_WAIT_L(0); PG8_MMA(1, 0, At, B0); PG8_BAR; PG8_SCHED;
            PG8_STAGE(PG8_SB(0, 1), b2 + hstep, voffB);
            PG8_WAIT_V(6); PG8_BAR; PG8_MMA(1, 1, At, B1); PG8_BAR;
            PG8_LDB(B0, 1, 0); PG8_SCHED; PG8_LDA(At, 1, 0); PG8_STAGE(PG8_SA(0, 1), a2 + hstep, voffA);
            PG8_WAIT_L(8); PG8_BAR; PG8_WAIT_L(0); PG8_MMA(0, 0, At, B0); PG8_BAR; PG8_SCHED;
            PG8_LDB(B1, 1, 1); PG8_STAGE(PG8_SB(1, 0), b3, voffB);
            PG8_BAR; PG8_WAIT_L(0); PG8_MMA(0, 1, At, B1); PG8_BAR;
            PG8_LDA(At, 1, 1); PG8_STAGE(PG8_SA(1, 0), a3, voffA);
            PG8_BAR; PG8_WAIT_L(0); PG8_MMA(1, 0, At, B0); PG8_BAR; PG8_SCHED;
            PG8_STAGE(PG8_SB(1, 1), b3 + hstep, voffB);
            PG8_WAIT_V(6); PG8_BAR; PG8_MMA(1, 1, At, B1); PG8_BAR;
            }
        }
        if constexpr (ALIGN_EPI) { if (wr == 0) PG8_BAR; }
        if constexpr (!Epi::AFTER_DRAIN) { E(acc, cur, wr, wc, fr, fq); S.done(cur); }
        if (!has_next) break;
#pragma unroll
        for (int a = 0; a < 2; ++a)
#pragma unroll
            for (int b = 0; b < 2; ++b)
#pragma unroll
                for (int m = 0; m < 4; ++m)
#pragma unroll
                    for (int n = 0; n < 2; ++n) acc[a][b][m][n] = (f32x4){0.f, 0.f, 0.f, 0.f};
        cur = nxt; cA = nA; cB = nB; ++ui;
        if constexpr (ALIGN_EPI) { if (wr == 1) PG8_BAR; }
    }
    PG8_WAIT_V(0);
    if constexpr (!ALIGN_EPI) { if (wr == 0) PG8_BAR; }
    PG8_BAR;
    if constexpr (Epi::AFTER_DRAIN) { E.fused(acc, cur, wr, wc, fr, fq, lds, wid, lane); S.done(cur); }
#undef PG8_SA
#undef PG8_SB
#undef PG8_STAGE
#undef PG8_LDA
#undef PG8_LDB
#undef PG8_MMA
#undef PG8_WAIT_V
#undef PG8_WAIT_L
#undef PG8_BAR
#undef PG8_SCHED
}
}
namespace att {
using bf16 = unsigned short;
using bf16x8 = __attribute__((ext_vector_type(8))) short;
using s16x4 = __attribute__((ext_vector_type(4))) short;
using f32x16 = __attribute__((ext_vector_type(16))) float;
using f32x8 = __attribute__((ext_vector_type(8))) float;
using f32x4 = __attribute__((ext_vector_type(4))) float;
using u32x4 = __attribute__((ext_vector_type(4))) unsigned;
#define SBAR() __builtin_amdgcn_sched_barrier(0)
constexpr float THRL = 6.0f;
__device__ __forceinline__ int crow(int r, int hi) { return (r & 3) + 8 * (r >> 2) + 4 * hi; }
__device__ __forceinline__ unsigned cvtpk(float lo, float hi) { unsigned r; asm volatile("v_cvt_pk_bf16_f32 %0, %1, %2" : "=v"(r) : "v"(lo), "v"(hi)); return r; }
__device__ __forceinline__ bf16x8 f8_to_bf(f32x8 x) { u32x4 w = {cvtpk(x[0], x[1]), cvtpk(x[2], x[3]), cvtpk(x[4], x[5]), cvtpk(x[6], x[7])}; return __builtin_bit_cast(bf16x8, w); }
template <int DQK> __device__ __forceinline__ int kswz(int row, int c) {
    if constexpr (DQK == 64) return row * 128 + ((c ^ ((row >> 1) & 7)) << 4);
    else return row * 192 + ((c ^ ((row >> 2) & 3)) << 4);
}
template <int NCB> __device__ __forceinline__ int v_st(int k, int c) { const int kk = (k & ~0xC) | ((k & 4) << 1) | ((k & 8) >> 1); return ((kk >> 3) * NCB + (c >> 5)) * 512 + ((kk & 7) * 32 + (c & 31)) * 2; }
__device__ __forceinline__ int v_rd_base(int lane) { return ((lane & 3) << 3) | (((lane >> 2) & 3) << 6) | (((lane >> 4) & 1) << 5) | (((lane >> 5) & 1) << 8); }
template <int OFF> __device__ __forceinline__ s16x4 tr_read(int vb) { s16x4 r; asm volatile("ds_read_b64_tr_b16 %0, %1 offset:%2" : "=&v"(r) : "v"(vb), "i"(OFF) : "memory"); return r; }
template <int NCB, int D0> __device__ __forceinline__ void pv_one(f32x16& od, int vb, bf16x8 pa0, bf16x8 pa1, bf16x8 pa2, bf16x8 pa3) {
    constexpr int KS = NCB * 1024, HF = NCB * 512, B0 = D0 * 512;
    const s16x4 l0 = tr_read<B0>(vb), h0 = tr_read<B0 + HF>(vb), l1 = tr_read<B0 + KS>(vb), h1 = tr_read<B0 + KS + HF>(vb);
    const s16x4 l2 = tr_read<B0 + 2 * KS>(vb), h2 = tr_read<B0 + 2 * KS + HF>(vb), l3 = tr_read<B0 + 3 * KS>(vb), h3 = tr_read<B0 + 3 * KS + HF>(vb);
    asm volatile("s_waitcnt lgkmcnt(0)" ::: "memory"); SBAR();
#define PK(L, H) (bf16x8){L[0], L[1], L[2], L[3], H[0], H[1], H[2], H[3]}
    od = __builtin_amdgcn_mfma_f32_32x32x16_bf16(pa0, PK(l0, h0), od, 0, 0, 0);
    od = __builtin_amdgcn_mfma_f32_32x32x16_bf16(pa1, PK(l1, h1), od, 0, 0, 0);
    od = __builtin_amdgcn_mfma_f32_32x32x16_bf16(pa2, PK(l2, h2), od, 0, 0, 0);
    od = __builtin_amdgcn_mfma_f32_32x32x16_bf16(pa3, PK(l3, h3), od, 0, 0, 0);
#undef PK
}
template <int NCB> __device__ __forceinline__ void pv_all(f32x16* o, int vb, bf16x8 pa0, bf16x8 pa1, bf16x8 pa2, bf16x8 pa3) {
    pv_one<NCB, 0>(o[0], vb, pa0, pa1, pa2, pa3); pv_one<NCB, 1>(o[1], vb, pa0, pa1, pa2, pa3);
    if constexpr (NCB == 4) { pv_one<NCB, 2>(o[2], vb, pa0, pa1, pa2, pa3); pv_one<NCB, 3>(o[3], vb, pa0, pa1, pa2, pa3); }
}
__device__ __forceinline__ void partialSM(f32x16& p0, f32x16& p1, float& m_reg, float& alpha) {
    float pmax = p0[0];
#pragma unroll
    for (int r = 1; r < 16; ++r) pmax = fmaxf(pmax, p0[r]);
#pragma unroll
    for (int r = 0; r < 16; ++r) pmax = fmaxf(pmax, p1[r]);
    { auto rr = __builtin_amdgcn_permlane32_swap(__float_as_uint(pmax), __float_as_uint(pmax), false, false); pmax = fmaxf(__uint_as_float(rr[0]), __uint_as_float(rr[1])); }
    float mn;
    if (__builtin_expect(__all(pmax - m_reg <= THRL), 1)) { mn = m_reg; alpha = 1.f; }
    else { mn = fmaxf(m_reg, pmax); alpha = __builtin_amdgcn_exp2f(m_reg - mn); m_reg = mn; }
#pragma unroll
    for (int r = 0; r < 16; ++r) { p0[r] -= mn; p1[r] -= mn; }
#pragma unroll
    for (int r = 0; r < 16; ++r) p0[r] = __builtin_amdgcn_exp2f(p0[r]);
}
__device__ __forceinline__ void finishSM(f32x16& p0, f32x16& p1, float alpha, float& l_reg, bf16x8& pa0, bf16x8& pa1, bf16x8& pa2, bf16x8& pa3) {
#pragma unroll
    for (int r = 0; r < 16; ++r) p1[r] = __builtin_amdgcn_exp2f(p1[r]);
    float ps = 0;
#pragma unroll
    for (int r = 0; r < 16; ++r) ps += p0[r];
#pragma unroll
    for (int r = 0; r < 16; ++r) ps += p1[r];
    { auto rr = __builtin_amdgcn_permlane32_swap(__float_as_uint(ps), __float_as_uint(ps), false, false); ps = __uint_as_float(rr[0]) + __uint_as_float(rr[1]); }
    l_reg = l_reg * alpha + ps;
#define PK4(P, BASE, OUT) do { unsigned a0 = cvtpk(P[BASE + 0], P[BASE + 1]), a1 = cvtpk(P[BASE + 2], P[BASE + 3]);   \
    unsigned b0 = cvtpk(P[BASE + 4], P[BASE + 5]), b1 = cvtpk(P[BASE + 6], P[BASE + 7]);                              \
    auto r0 = __builtin_amdgcn_permlane32_swap(a0, b0, false, false); auto r1 = __builtin_amdgcn_permlane32_swap(a1, b1, false, false); \
    u32x4 w = {r0[0], r1[0], r0[1], r1[1]}; OUT = __builtin_bit_cast(bf16x8, w); } while (0)
    PK4(p0, 0, pa0); PK4(p0, 8, pa1); PK4(p1, 0, pa2); PK4(p1, 8, pa3);
#undef PK4
}

constexpr int L_V = 0, L_K = 32768, L_CK = 57344, L_WS = 57856, L_OST = 61440;
template <int TYPE> struct ATraits;
template <> struct ATraits<0> { static constexpr int DQK = 96, DV = 64; };
template <> struct ATraits<1> { static constexpr int DQK = 64, DV = 64; };
template <> struct ATraits<2> { static constexpr int DQK = 64, DV = 128; };
struct ASrc {
    const bf16* q; int ldq;
    const bf16* k0; int ldk0;
    const bf16* k1; int ldk1;
    const bf16* v; int ldv;
    const float* ck;
};
template <int TYPE>
__device__ __forceinline__ void attn_unit(const ASrc& S, int qb, char* lds, f32x16 (&o)[ATraits<TYPE>::DV / 32]) {
    constexpr int DQK = ATraits<TYPE>::DQK, DV = ATraits<TYPE>::DV, NCB = DV / 32, ND0 = DQK / 16, KCH = DQK / 8, VCH = DV / 8;
    constexpr int KB = 64 * DQK * 2, VB = 64 * DV * 2;
    const int tid = threadIdx.x, lane = tid & 63, r32 = lane & 31, hi = lane >> 5; const int wid = __builtin_amdgcn_readfirstlane(tid >> 6);
    char* V_lds = lds + L_V; char* K_lds = lds + L_K; float* CK_lds = (float*)(lds + L_CK);
    float* ws = (float*)(lds + L_WS) + wid * 64; float* li_l = ws; float* al_l = ws + 32;
    float m_reg = -1e30f, l_reg = 0.f; bf16x8 qr[ND0];
#pragma unroll
    for (int d = 0; d < NCB; ++d) o[d] = f32x16{};
    { const bf16* Qw = S.q + (size_t)(qb * 256 + wid * 32 + r32) * S.ldq + hi * 8;
#pragma unroll
      for (int d0 = 0; d0 < ND0; ++d0) qr[d0] = *reinterpret_cast<const bf16x8*>(Qw + d0 * 16); }
    const int NT = 4 * qb + 4, Lw = 4 * qb + (wid >> 1);
    const int vb0 = (int)(uintptr_t)V_lds + v_rd_base(lane);
    constexpr int NVI = (64 * VCH) / 512;
    bf16x8 ksr0, ksr1, vsr[NVI]; f32x4 cksr = {0.f, 0.f, 0.f, 0.f};
    const int krow = tid >> 3, kc = tid & 7, k1row = (tid >> 2) & 63, k1c = tid & 3;
    const unsigned koff0 = (unsigned)(krow * S.ldk0 + kc * 8), koff1 = (unsigned)(k1row * S.ldk1 + k1c * 8);
    unsigned voff[NVI]; int vlds[NVI];
#pragma unroll
    for (int i = 0; i < NVI; ++i) { const int id = tid + i * 512, row = id / VCH, c = id % VCH; voff[i] = (unsigned)(row * S.ldv + c * 8); vlds[i] = v_st<NCB>(row, c * 8); }
    const int klds0 = kswz<DQK>(krow, kc), klds1 = (TYPE == 0) ? kswz<DQK>(k1row, 8 + k1c) : 0;
#define SLOAD(t) do { const size_t k0_ = (size_t)(t) * 64;                                                                     \
    ksr0 = *reinterpret_cast<const bf16x8*>(S.k0 + k0_ * S.ldk0 + koff0);                                                       \
    if (TYPE == 0 && tid < 256) ksr1 = *reinterpret_cast<const bf16x8*>(S.k1 + k0_ * S.ldk1 + koff1);                           \
    _Pragma("unroll") for (int i_ = 0; i_ < NVI; ++i_) vsr[i_] = *reinterpret_cast<const bf16x8*>(S.v + k0_ * S.ldv + voff[i_]); \
    if (TYPE == 1 && tid < 16) cksr = *reinterpret_cast<const f32x4*>(S.ck + k0_ + tid * 4); } while (0)
#define SWRITE(b) do {                                                                                                          \
    *reinterpret_cast<bf16x8*>(K_lds + (b) * KB + klds0) = ksr0;                                                                \
    if (TYPE == 0 && tid < 256) *reinterpret_cast<bf16x8*>(K_lds + (b) * KB + klds1) = ksr1;                                    \
    _Pragma("unroll") for (int i_ = 0; i_ < NVI; ++i_) *reinterpret_cast<bf16x8*>(V_lds + (b) * VB + vlds[i_]) = vsr[i_];       \
    if (TYPE == 1 && tid < 16) *reinterpret_cast<f32x4*>(CK_lds + (b) * 64 + tid * 4) = cksr; } while (0)
#define QKT(P0, P1, b) do { const char* Kb_ = K_lds + (b) * KB;                                                                                   \
    if (TYPE == 1) { const float* ck_ = CK_lds + (b) * 64 + 4 * hi;                                                                                \
        _Pragma("unroll") for (int g_ = 0; g_ < 4; ++g_) { const f32x4 a_ = *reinterpret_cast<const f32x4*>(ck_ + 8 * g_), b_ = *reinterpret_cast<const f32x4*>(ck_ + 32 + 8 * g_); \
            _Pragma("unroll") for (int j_ = 0; j_ < 4; ++j_) { P0[4 * g_ + j_] = a_[j_]; P1[4 * g_ + j_] = b_[j_]; } } }                          \
    else { P0 = f32x16{}; P1 = f32x16{}; }                                                                                                         \
    _Pragma("unroll") for (int d0_ = 0; d0_ < ND0; ++d0_) {                                                                                        \
        const bf16x8 b0_ = *reinterpret_cast<const bf16x8*>(Kb_ + kswz<DQK>(r32, 2 * d0_ + hi));                                                   \
        const bf16x8 b1_ = *reinterpret_cast<const bf16x8*>(Kb_ + 32 * (DQK * 2) + kswz<DQK>(r32, 2 * d0_ + hi));                                  \
        P0 = __builtin_amdgcn_mfma_f32_32x32x16_bf16(b0_, qr[d0_], P0, 0, 0, 0);                                                                   \
        P1 = __builtin_amdgcn_mfma_f32_32x32x16_bf16(b1_, qr[d0_], P1, 0, 0, 0); } } while (0)
#define DIAGMASK(P0, P1) do { const int rin_ = 32 * (wid & 1) + r32;                                                                              \
    _Pragma("unroll") for (int r_ = 0; r_ < 16; ++r_) { const int c_ = crow(r_, hi); if (c_ > rin_) P0[r_] = -INFINITY; if (c_ + 32 > rin_) P1[r_] = -INFINITY; } } while (0)
#define RESC(a) do { if (__any((a) < 1.f)) { if (hi == 0) al_l[r32] = (a); asm volatile("s_waitcnt lgkmcnt(0)" ::: "memory");                      \
    _Pragma("unroll") for (int d_ = 0; d_ < NCB; ++d_) _Pragma("unroll") for (int r_ = 0; r_ < 16; ++r_) o[d_][r_] *= al_l[crow(r_, hi)]; } } while (0)
    f32x16 p0, p1; float alpha = 1.f; bf16x8 pa0, pa1, pa2, pa3;
    SLOAD(0); SWRITE(0); __syncthreads();
    for (int j = 0; j < NT; ++j) {
        if (j + 1 < NT) SLOAD(j + 1);
        SBAR();
        if (j <= Lw) {
            QKT(p0, p1, j & 1);
            if (TYPE == 1 && j == Lw) DIAGMASK(p0, p1);
            partialSM(p0, p1, m_reg, alpha);
            RESC(alpha);
            finishSM(p0, p1, alpha, l_reg, pa0, pa1, pa2, pa3); SBAR();
            pv_all<NCB>(o, vb0 + (j & 1) * VB, pa0, pa1, pa2, pa3);
        }
        SBAR();
        if (j + 1 < NT) SWRITE((j + 1) & 1);
        __syncthreads();
    }
    if (hi == 0) li_l[r32] = l_reg; asm volatile("s_waitcnt lgkmcnt(0)" ::: "memory");
#pragma unroll
    for (int r = 0; r < 16; ++r) { const float rl = __builtin_amdgcn_rcpf(li_l[crow(r, hi)]);
#pragma unroll
        for (int d = 0; d < NCB; ++d) o[d][r] *= rl; }
#undef SLOAD
#undef SWRITE
#undef QKT
#undef DIAGMASK
#undef RESC
}
template <int DV>
__device__ __forceinline__ void store_o_bf16(const f32x16 (&o)[DV / 32], char* lds, bf16* Ow  , int ldo) {
    const int lane = threadIdx.x & 63, r32 = lane & 31, hi = lane >> 5; const int wid = __builtin_amdgcn_readfirstlane(threadIdx.x >> 6);
    __hip_bfloat16* stg = (__hip_bfloat16*)(lds + L_OST + wid * 8192);
#pragma unroll
    for (int r = 0; r < 16; ++r) { const int orow = crow(r, hi);
#pragma unroll
        for (int d = 0; d < DV / 32; ++d) stg[orow * DV + d * 32 + r32] = __float2bfloat16(o[d][r]); }
    asm volatile("s_waitcnt lgkmcnt(0)" ::: "memory");
    constexpr int CPR = DV / 8, RPI = 64 / CPR;
#pragma unroll
    for (int i = 0; i < 32 / RPI; ++i) { const int row = i * RPI + lane / CPR, ch = lane % CPR;
        const u32x4 v = *(const u32x4*)((const char*)stg + (row * DV + ch * 8) * 2); *(u32x4*)(Ow + (size_t)row * ldo + ch * 8) = v; }
    asm volatile("s_waitcnt lgkmcnt(0)" ::: "memory");
}

struct SSrc {
    const bf16* q; int ldq;
    const bf16* k0; int ldk0; const bf16* k1; int ldk1; const bf16* vb; int ldvb;
    const float* kc; const float* kn; int ldkf; const float* vc; const float* vn; int ldvf;
    const float* ck;
};
template <int TYPE>
__device__ __forceinline__ void sample_unit(const SSrc& S, int split, char* wlds  , float* wscr  , float* part) {
    constexpr int DQK = ATraits<TYPE>::DQK, DV = ATraits<TYPE>::DV, NCB = DV / 32, ND0 = DQK / 16, VCH = DV / 8;
    const int lane = threadIdx.x & 63, r32 = lane & 31, hi = lane >> 5;
    bf16x8 qr[ND0]; f32x16 o[NCB]; float m_reg = -1e30f, l_reg = 0.f;
#pragma unroll
    for (int d = 0; d < NCB; ++d) o[d] = f32x16{};
    { const bf16* Qw = S.q + (size_t)r32 * S.ldq + hi * 8;
#pragma unroll
      for (int d0 = 0; d0 < ND0; ++d0) qr[d0] = *reinterpret_cast<const bf16x8*>(Qw + d0 * 16); }
    const int vb0 = (int)(uintptr_t)wlds + v_rd_base(lane);
    const int ntile = (split == NSPLIT - 1) ? 5 : 4;
    for (int t = 0; t < ntile; ++t) {
        const bool newt = (t == 4); const int key0 = newt ? PAST : split * 256 + t * 64;
        f32x16 p0, p1;
        if constexpr (TYPE == 1) { const float* ck = S.ck + key0 + 4 * hi;
#pragma unroll
            for (int g = 0; g < 4; ++g) { const f32x4 a = *reinterpret_cast<const f32x4*>(ck + 8 * g); f32x4 b = a; if (!newt) b = *reinterpret_cast<const f32x4*>(ck + 32 + 8 * g);
#pragma unroll
                for (int j = 0; j < 4; ++j) { p0[4 * g + j] = a[j]; p1[4 * g + j] = b[j]; } } }
        else { p0 = f32x16{}; p1 = f32x16{}; }
#pragma unroll
        for (int d0 = 0; d0 < ND0; ++d0) {
            bf16x8 b0, b1; const int col = d0 * 16 + hi * 8;
            const int ka = key0 + r32, kb = newt ? key0 + r32 : key0 + 32 + r32;
            if constexpr (TYPE == 0) {
                if (d0 < 4) { b0 = *reinterpret_cast<const bf16x8*>(S.k0 + (size_t)ka * S.ldk0 + col); b1 = *reinterpret_cast<const bf16x8*>(S.k0 + (size_t)kb * S.ldk0 + col); }
                else { b0 = *reinterpret_cast<const bf16x8*>(S.k1 + (size_t)ka * S.ldk1 + col - 64); b1 = *reinterpret_cast<const bf16x8*>(S.k1 + (size_t)kb * S.ldk1 + col - 64); }
            } else {
                const float* pa = newt ? (S.kn + (size_t)(ka - PAST) * S.ldkf) : (S.kc + (size_t)ka * S.ldkf);
                const float* pb = newt ? (S.kn + (size_t)(kb - PAST) * S.ldkf) : (S.kc + (size_t)kb * S.ldkf);
                b0 = f8_to_bf(*reinterpret_cast<const f32x8*>(pa + col)); b1 = f8_to_bf(*reinterpret_cast<const f32x8*>(pb + col));
            }
            p0 = __builtin_amdgcn_mfma_f32_32x32x16_bf16(b0, qr[d0], p0, 0, 0, 0);
            p1 = __builtin_amdgcn_mfma_f32_32x32x16_bf16(b1, qr[d0], p1, 0, 0, 0);
        }
        if (newt) {
#pragma unroll
            for (int r = 0; r < 16; ++r) { p1[r] = -INFINITY; if (TYPE == 1 && crow(r, hi) > r32) p0[r] = -INFINITY; }
        }
#pragma unroll
        for (int i = 0; i < VCH; ++i) { const int id = lane + i * 64, row = id / VCH, c = id % VCH; int kk = key0 + row; if (newt) kk = key0 + (row & 31);
            bf16x8 vv;
            if constexpr (TYPE == 0) vv = *reinterpret_cast<const bf16x8*>(S.vb + (size_t)kk * S.ldvb + c * 8);
            else { const float* pv = newt ? (S.vn + (size_t)(kk - PAST) * S.ldvf) : (S.vc + (size_t)kk * S.ldvf); vv = f8_to_bf(*reinterpret_cast<const f32x8*>(pv + c * 8)); }
            *reinterpret_cast<bf16x8*>(wlds + v_st<NCB>(row, c * 8)) = vv; }
        float pmax = p0[0];
#pragma unroll
        for (int r = 1; r < 16; ++r) pmax = fmaxf(pmax, p0[r]);
#pragma unroll
        for (int r = 0; r < 16; ++r) pmax = fmaxf(pmax, p1[r]);
        { auto rr = __builtin_amdgcn_permlane32_swap(__float_as_uint(pmax), __float_as_uint(pmax), false, false); pmax = fmaxf(__uint_as_float(rr[0]), __uint_as_float(rr[1])); }
        const float mn = fmaxf(m_reg, pmax), alpha = __builtin_amdgcn_exp2f(m_reg - mn); m_reg = mn;
#pragma unroll
        for (int r = 0; r < 16; ++r) { p0[r] = __builtin_amdgcn_exp2f(p0[r] - mn); p1[r] = __builtin_amdgcn_exp2f(p1[r] - mn); }
        float ps = 0.f;
#pragma unroll
        for (int r = 0; r < 16; ++r) ps += p0[r] + p1[r];
        { auto rr = __builtin_amdgcn_permlane32_swap(__float_as_uint(ps), __float_as_uint(ps), false, false); ps = __uint_as_float(rr[0]) + __uint_as_float(rr[1]); }
        l_reg = l_reg * alpha + ps;
        if (hi == 0) wscr[r32] = alpha; asm volatile("s_waitcnt lgkmcnt(0)" ::: "memory");
#pragma unroll
        for (int d = 0; d < NCB; ++d)
#pragma unroll
            for (int r = 0; r < 16; ++r) o[d][r] *= wscr[crow(r, hi)];
        bf16x8 pa0, pa1, pa2, pa3;
#define PK4(P, BASE, OUT) do { unsigned a0 = cvtpk(P[BASE + 0], P[BASE + 1]), a1 = cvtpk(P[BASE + 2], P[BASE + 3]);   \
    unsigned b0 = cvtpk(P[BASE + 4], P[BASE + 5]), b1 = cvtpk(P[BASE + 6], P[BASE + 7]);                              \
    auto r0 = __builtin_amdgcn_permlane32_swap(a0, b0, false, false); auto r1 = __builtin_amdgcn_permlane32_swap(a1, b1, false, false); \
    u32x4 w = {r0[0], r1[0], r0[1], r1[1]}; OUT = __builtin_bit_cast(bf16x8, w); } while (0)
        PK4(p0, 0, pa0); PK4(p0, 8, pa1); PK4(p1, 0, pa2); PK4(p1, 8, pa3);
#undef PK4
        asm volatile("s_waitcnt lgkmcnt(0)" ::: "memory"); SBAR();
        pv_all<NCB>(o, vb0, pa0, pa1, pa2, pa3);
        asm volatile("s_waitcnt lgkmcnt(0)" ::: "memory"); SBAR();
    }
#pragma unroll
    for (int r = 0; r < 16; ++r) { const int orow = crow(r, hi);
#pragma unroll
        for (int d = 0; d < NCB; ++d) part[orow * DV + d * 32 + r32] = o[d][r]; }
    if (hi == 0) { part[32 * DV + r32] = m_reg; part[32 * DV + 32 + r32] = l_reg; }
}
#undef SBAR
}
constexpr int NWAVES = 8;
#define GAS __attribute__((address_space(1)))
#define LAS __attribute__((address_space(3)))
typedef unsigned short bf16;
typedef unsigned v4u __attribute__((ext_vector_type(4)));
typedef unsigned v2u __attribute__((ext_vector_type(2)));
typedef float f32x4 __attribute__((ext_vector_type(4)));
typedef float f32x8 __attribute__((ext_vector_type(8)));
typedef short bf16x8 __attribute__((ext_vector_type(8)));
typedef GAS unsigned gu32;
#define RLX_AGENT __ATOMIC_RELAXED, __HIP_MEMORY_SCOPE_AGENT
#define LDS_WAIT() asm volatile("s_waitcnt lgkmcnt(0)" ::: "memory")
#define VM_WAIT() asm volatile("s_waitcnt vmcnt(0)" ::: "memory")
__device__ __forceinline__ unsigned pk2(float lo, float hi) { unsigned r; asm volatile("v_cvt_pk_bf16_f32 %0, %1, %2" : "=v"(r) : "v"(lo), "v"(hi)); return r; }
__device__ __forceinline__ float bf2f(unsigned short b) { return __uint_as_float((unsigned)b << 16); }

#define XB_TMO      128
#define XB_XCNT(j)  (256  + 64 * (j))
#define XB_XSUB(j)  (1280 + 64 * (j))
#define XB_XGEN(j)  (2304 + 64 * (j))
#define XB_TOP      3328
#define XB_TOPGEN   3392
#define XCD_BAR_WORDS 3456
#define XB_SPIN_CAP (1u << 22)

__device__ __forceinline__ unsigned xb_ld(unsigned* p)              { return __hip_atomic_load(p, __ATOMIC_RELAXED, __HIP_MEMORY_SCOPE_AGENT); }
__device__ __forceinline__ unsigned xb_add(unsigned* p, unsigned v) { return __hip_atomic_fetch_add(p, v, __ATOMIC_RELAXED, __HIP_MEMORY_SCOPE_AGENT); }
__device__ __forceinline__ unsigned xb_xcc_id() { return (unsigned)__builtin_amdgcn_s_getreg((3 << 11) | 20) & 0xFu; }
#define XB_SPIN(cond, bar) do { unsigned _sp = 0; while (cond) { __builtin_amdgcn_s_sleep(1); \
    if ((++_sp & 255u) == 0u) { if (xb_ld(&(bar)[XB_TMO])) break; if (_sp > XB_SPIN_CAP) { atomicAdd(&(bar)[XB_TMO], 1u); break; } } } } while (0)

struct XcdBarrier {
    unsigned* bar; unsigned x;
    volatile LAS unsigned* st;
};

__device__ __forceinline__ XcdBarrier xcd_barrier_post(unsigned* bar, volatile LAS unsigned* st) {
    XcdBarrier b; b.bar = bar; b.x = xb_xcc_id(); b.st = st;
    if (threadIdx.x == 0) (void)xb_add(&bar[XB_XCNT(b.x)], 1u);
    return b;
}
__device__ __forceinline__ void xcd_barrier_complete(unsigned* bar, unsigned x, unsigned& nloc, unsigned& nx) {
    const unsigned G = gridDim.x * gridDim.y * gridDim.z;
    unsigned sum, cnt, mine, sp = 0u;
    for (;;) {
        sum = 0u; cnt = 0u; mine = 0u;
#pragma unroll
        for (unsigned j = 0; j < 16; ++j) { const unsigned c = xb_ld(&bar[XB_XCNT(j)]); sum += c; cnt += (c > 0u) ? 1u : 0u; mine = (j == x) ? c : mine; }
        if (sum == G) break;
        __builtin_amdgcn_s_sleep(1);
        if ((++sp & 255u) == 0u) { if (xb_ld(&bar[XB_TMO])) break; if (sp > XB_SPIN_CAP) { atomicAdd(&bar[XB_TMO], 1u); break; } }
    }
    nloc = mine > 0u ? mine : 1u; nx = cnt > 0u ? cnt : 1u;
}

__device__ __forceinline__ void xcd_barrier(const XcdBarrier& b) {
    asm volatile("s_waitcnt vmcnt(0)" ::: "memory");
    __syncthreads();
    if (threadIdx.x == 0) {
        unsigned* bar = b.bar;
        __builtin_amdgcn_s_waitcnt(0);
        unsigned nloc = b.st[0], nx = b.st[1];
        if (nloc == 0u) { xcd_barrier_complete(bar, b.x, nloc, nx); b.st[0] = nloc; b.st[1] = nx; }
        const unsigned old = xb_add(&bar[XB_XSUB(b.x)], 1u);
        const unsigned gen = old / nloc;
        if (old + 1u == (gen + 1u) * nloc) {
            __builtin_amdgcn_fence(__ATOMIC_RELEASE, "agent");
            asm volatile("s_waitcnt vmcnt(0)" ::: "memory");
            const unsigned og = xb_add(&bar[XB_TOP], 1u);
            const unsigned tg = og / nx;
            if (og + 1u == (tg + 1u) * nx) xb_add(&bar[XB_TOPGEN], 1u);
            else XB_SPIN(xb_ld(&bar[XB_TOPGEN]) == tg, bar);
            __builtin_amdgcn_fence(__ATOMIC_ACQUIRE, "agent");
            xb_add(&bar[XB_XGEN(b.x)], 1u);
            asm volatile("s_waitcnt vmcnt(0)" ::: "memory");
        } else {
            XB_SPIN(xb_ld(&bar[XB_XGEN(b.x)]) == gen, bar);
            __builtin_amdgcn_fence(__ATOMIC_ACQUIRE, "agent");
            asm volatile("s_waitcnt vmcnt(0)" ::: "memory");
        }
    }
    __syncthreads();
}


struct Frame { LAS unsigned char* lds; int tid, lane, wave, vcu, G; };
struct Args { const float* in[25]; float* out; unsigned char* ws; int ph_lo, ph_hi, use_bar, pad; };
enum { I_XP = 0, I_XS, I_CCKV, I_CKR, I_CFK, I_CFV, I_CLOGF, I_CDK, I_CDV, I_GMIX, I_AWIN, I_AGQ, I_AWUQ, I_AGKV, I_AWUKV, I_ABF, I_AWOUT, I_CWIN, I_CLAM, I_CGSUB, I_CWOUT, I_GMLP, I_WUP, I_WDN, I_GFIN };

__device__ __forceinline__ float wave_sum(float v) {
#pragma unroll
    for (int o = 1; o < 64; o <<= 1) v += __shfl_xor(v, o);
    return v;
}
__device__ __forceinline__ int ain_src(int n) {
    if (n < 768) return n;
    if (n < 2304) return n + 32;
    if (n < 2336) return n - 2304 + 768;
    if (n < 2344) return n;
    return -1;
}
__device__ __forceinline__ void tr_item(const float* W, int ldw, int K, const float* gain, bf16* WT, int item, int nblk, bool ainmap, LAS float* scr, int lane) {
    const int kb = item / nblk, nb = item % nblk, k0 = 64 * kb, n0 = 32 * nb;
    const int n = n0 + (lane & 31); const int src = ainmap ? ain_src(n) : n;
#pragma unroll 8
    for (int i = 0; i < 32; ++i) { const int kk = 2 * i + (lane >> 5);
        float v = 0.f; if (src >= 0) { v = W[(size_t)(k0 + kk) * ldw + src]; if (gain) v *= gain[k0 + kk]; }
        scr[kk * 33 + (lane & 31)] = v; }
    LDS_WAIT(); asm volatile("" ::: "memory");
    const int c = lane & 7;
#pragma unroll
    for (int j = 0; j < 4; ++j) { const int nn = (lane >> 3) + 8 * j; const LAS float* s = scr + (8 * c) * 33 + nn;
        v4u o; o.x = pk2(s[0 * 33], s[1 * 33]); o.y = pk2(s[2 * 33], s[3 * 33]); o.z = pk2(s[4 * 33], s[5 * 33]); o.w = pk2(s[6 * 33], s[7 * 33]);
        *(GAS v4u*)(WT + (size_t)(n0 + nn) * K + k0 + 8 * c) = o; }
    LDS_WAIT(); asm volatile("" ::: "memory");
}
__device__ __forceinline__ void rope_entry(int pos, float chi, float clo, float& c, float& s) {
    const float p = (float)pos; const float t = p * chi; const float e = fmaf(p, chi, -t);
    float fr = t - rintf(t); fr += e + p * clo;
    c = __builtin_amdgcn_cosf(fr); s = __builtin_amdgcn_sinf(fr);
}

__device__ __forceinline__ void p0_prologue(const Frame& F, const Args& a) {
    unsigned char* ws = a.ws;
    LAS float* scr = (LAS float*)(F.lds + RING_OFF + F.wave * 16384);
    const int gw = F.vcu * NWAVES + F.wave, NGW = F.G * NWAVES;
    constexpr int I0 = 16 * 80, I1 = 8 * 24, I2 = 4 * 32, I3 = 16 * 32, I4 = 16 * 128, I5 = 64 * 32, I6 = 16 * 96, I7 = 16 * 32;
    constexpr int NITEMS = I0 + I1 + I2 + I3 + 2 * I4 + 2 * I5 + I6 + I7;
    for (int it = gw; it < NITEMS; it += NGW) {
        int r = it;
        if (r < I0) { tr_item(a.in[I_AWIN], A_IN, DM, a.in[I_GMIX], (bf16*)(ws + WS_WAIN), r, 80, true, scr, F.lane); continue; } r -= I0;
        if (r < I1) { tr_item(a.in[I_AWUQ], NQM, QLORA, a.in[I_AGQ], (bf16*)(ws + WS_WUQ), r, 24, false, scr, F.lane); continue; } r -= I1;
        if (r < I2) { tr_item(a.in[I_AWUKV], NKV, KVLORA, nullptr, (bf16*)(ws + WS_WUKV), r, 32, false, scr, F.lane); continue; } r -= I2;
        if (r < I3) { tr_item(a.in[I_AWOUT], DM, DM, nullptr, (bf16*)(ws + WS_WAOUT), r, 32, false, scr, F.lane); continue; } r -= I3;
        if (r < 2 * I4) { const int l = r / I4; tr_item(a.in[I_WUP] + (size_t)l * DM * DFF, DFF, DM, a.in[I_GMLP] + l * DM, (bf16*)(ws + WS_WUP) + (size_t)l * DFF * DM, r % I4, 128, false, scr, F.lane); continue; } r -= 2 * I4;
        if (r < 2 * I5) { const int l = r / I5; tr_item(a.in[I_WDN] + (size_t)l * DFF * DM, DM, DFF, nullptr, (bf16*)(ws + WS_WDN) + (size_t)l * DM * DFF, r % I5, 32, false, scr, F.lane); continue; } r -= 2 * I5;
        if (r < I6) { tr_item(a.in[I_CWIN], NC, DM, a.in[I_GMIX] + DM, (bf16*)(ws + WS_WCIN), r, 96, false, scr, F.lane); continue; } r -= I6;
        tr_item(a.in[I_CWOUT], DM, DM, nullptr, (bf16*)(ws + WS_WCOUT), r, 32, false, scr, F.lane);
    }
    { const int gt = F.vcu * (NWAVES * 64) + F.tid, NGT = F.G * NWAVES * 64;
      float* t16 = (float*)(ws + WS_TAB16); float* t8 = (float*)(ws + WS_TAB8);
      for (int e = gt; e < 8192 * 24; e += NGT) {
          float c, s;
          if (e < 8192 * 16) { const int pos = e >> 4, i = e & 15; rope_entry(pos, ROPE16_HI[i], ROPE16_LO[i], c, s); t16[pos * 32 + i] = c; t16[pos * 32 + 16 + i] = s; }
          else { const int e2 = e - 8192 * 16, pos = e2 >> 3, i = e2 & 7; rope_entry(pos, ROPE8_HI[i], ROPE8_LO[i], c, s); t8[pos * 16 + i] = c; t8[pos * 16 + 8 + i] = s; }
      } }
    { bf16* XB = (bf16*)(ws + WS_XB); float* SSQ = (float*)(ws + WS_SSQ);
      for (int m = gw; m < MT; m += NGW) {
          const float* xrow = (m < MP) ? (a.in[I_XP] + (size_t)m * DM) : (a.in[I_XS] + (size_t)(m - MP) * DM);
          const GAS f32x4* xr = (const GAS f32x4*)xrow + F.lane; f32x4 v[4]; float s = 0.f;
#pragma unroll
          for (int j = 0; j < 4; ++j) { v[j] = xr[64 * j]; s += (v[j].x * v[j].x + v[j].y * v[j].y) + (v[j].z * v[j].z + v[j].w * v[j].w); }
          s = wave_sum(s);
          GAS v2u* o8 = (GAS v2u*)(XB + (size_t)m * DM) + F.lane;
#pragma unroll
          for (int j = 0; j < 4; ++j) { v2u w; w.x = pk2(v[j].x, v[j].y); w.y = pk2(v[j].z, v[j].w); o8[64 * j] = w; }
          if (F.lane < 16) SSQ[(size_t)m * 16 + F.lane] = (F.lane == 0) ? s : 0.f;
      } }
    { const long gt = (long)F.vcu * (NWAVES * 64) + F.tid, NGT = (long)F.G * NWAVES * 64;
      bf16* CKVB = (bf16*)(ws + WS_R + R_CKVB); bf16* KRB = (bf16*)(ws + WS_R + R_KRB);
      constexpr long NC8 = (long)NBS * PAST * (KVLORA / 8), NK8 = (long)NBS * PAST * 4;
      for (long i = gt; i < NC8 + NK8; i += NGT) {
          if (i < NC8) { const long row = i >> 5; const int c = (int)(i & 31) * 8; const int b = (int)(row >> 12), j = (int)(row & 4095);
              const f32x8 x = *(const f32x8*)(a.in[I_CCKV] + row * KVLORA + c);
              v4u w; w.x = pk2(x[0], x[1]); w.y = pk2(x[2], x[3]); w.z = pk2(x[4], x[5]); w.w = pk2(x[6], x[7]);
              *(v4u*)(CKVB + ((size_t)MP + (size_t)b * KVL + j) * KVLORA + c) = w; }
          else { const long i2 = i - NC8; const long row = i2 >> 2; const int c = (int)(i2 & 3) * 8; const int b = (int)(row >> 12), j = (int)(row & 4095);
              const f32x8 x = *(const f32x8*)(a.in[I_CKR] + row * 32 + c);
              v4u w; w.x = pk2(x[0], x[1]); w.y = pk2(x[2], x[3]); w.z = pk2(x[4], x[5]); w.w = pk2(x[6], x[7]);
              *(v4u*)(KRB + ((size_t)MP + (size_t)b * KVL + j) * 32 + c) = w; }
      } }
}

__device__ __forceinline__ void scan_seq(const Args& a, int q, int lane) {
    unsigned char* ws = a.ws; const float* out = a.out;
    const bool prm = q < 64; const int qq = prm ? q : q - 64; const int b = qq >> 3, h = qq & 7;
    const int len = prm ? SEQ : KVL, CH = prm ? 128 : 65;
    float* dst = prm ? ((float*)(ws + WS_R + R_CUMP) + (size_t)qq * SEQ) : ((float*)(ws + WS_R + R_CUMS) + (size_t)qq * KVL);
    const float* srcp = out + O_LOGF_P + (size_t)b * SEQ * 8 + h;
    const float* srcc = a.in[I_CLOGF] + (size_t)b * PAST * 8 + h;
    const float* srcn = out + O_LOGF_S + (size_t)b * DSEQ * 8 + h;
    double run = 0.0;
    for (int i = 0; i < CH; ++i) { const int t = lane * CH + i; if (t < len) { const float v = prm ? srcp[(size_t)t * 8] : (t < PAST ? srcc[(size_t)t * 8] : srcn[(size_t)(t - PAST) * 8]); run += (double)v; } }
    double incl = run;
#pragma unroll
    for (int o = 1; o < 64; o <<= 1) { const double t = __shfl_up(incl, o); if (lane >= o) incl += t; }
    run = incl - run;
    for (int i = 0; i < CH; ++i) { const int t = lane * CH + i; if (t < len) { const float v = prm ? srcp[(size_t)t * 8] : (t < PAST ? srcc[(size_t)t * 8] : srcn[(size_t)(t - PAST) * 8]); run += (double)v; dst[t] = (float)(-run * 1.4426950408889634); } }
}

__device__ __forceinline__ float diff_lambda(const float* lamp, int lane) {
    const float s1 = wave_sum(lamp[lane] * lamp[64 + lane]), s2 = wave_sum(lamp[128 + lane] * lamp[192 + lane]);
    return __expf(s1) - __expf(s2) + LAM_INIT;
}

constexpr int N_PHASES = 15;
#ifndef MK_PER_PHASE
#define MK_PER_PHASE 0
#endif
#ifndef MK_PH_END
#define MK_PH_END N_PHASES
#endif

__global__ void __launch_bounds__(NWAVES * 64, 2) mk_fwd(Args args) {
    extern __shared__ __attribute__((aligned(16))) unsigned char lds[];
    Frame F;
    F.lds = (LAS unsigned char*)lds;
    F.tid = threadIdx.x; F.lane = F.tid & 63; F.wave = __builtin_amdgcn_readfirstlane(F.tid >> 6);
    F.G = gridDim.x; { const int bx = blockIdx.x; F.vcu = (F.G % 8 == 0) ? (bx % 8) * (F.G / 8) + bx / 8 : bx; }
    unsigned char* ws = args.ws; float* out = args.out;
    gu32* ctl = (gu32*)(ws + WS_CTL);
    for (int u = F.tid; u < (LDS_BYTES - LDSCTL_OFF) / 4; u += NWAVES * 64) ((LAS unsigned*)(F.lds + LDSCTL_OFF))[u] = 0u;
    __syncthreads();
    volatile LAS unsigned* MISC = (volatile LAS unsigned*)(F.lds + LDSCTL_OFF);
    XcdBarrier bar; bar.bar = (unsigned*)(ctl + CW_BAR); bar.x = 0; bar.st = nullptr;
    if (args.use_bar) bar = xcd_barrier_post((unsigned*)(ctl + CW_BAR), MISC);
    const int lo = args.ph_lo, hi = args.ph_hi;
#ifndef MK_ONLY
#define MK_ONLY -1
#endif
#define IN(k) ((MK_ONLY < 0 || MK_ONLY == (k)) && lo <= (k) && (k) < hi)
#ifndef MK_SUB
#define MK_SUB 0xff
#endif
#define SUB(bit) ((MK_SUB >> (bit)) & 1)
#define SEAM(k) do { if (IN(k) && IN((k) + 1)) xcd_barrier(bar); } while (0)

    bf16* XB = (bf16*)(ws + WS_XB); float* SSQ = (float*)(ws + WS_SSQ); float* X = out + O_Y;
    unsigned char* R = ws + WS_R;
    bf16* OB = (bf16*)(R + R_O);
    const float* TAB16 = (const float*)(ws + WS_TAB16); const float* TAB8 = (const float*)(ws + WS_TAB8);
    const int gw = F.vcu * NWAVES + F.wave, NGW = F.G * NWAVES;

    if (IN(0)) { p0_prologue(F, args); } SEAM(0);

    if (IN(1)) {
        pg8::Gemm g{XB, (const bf16*)(ws + WS_WAIN), MT, NA, DM}; pg8::StaticOrder S; S.init(MT, NA, F.G, (int)blockIdx.x);
        pg8::EpiAin E{SSQ, (bf16*)(R + R_QLAT), (float*)(R + R_QSSQ), (bf16*)(R + R_CKVB), (bf16*)(R + R_KRB), (bf16*)(R + R_FQ), (bf16*)(R + R_FK), (bf16*)(R + R_FV),
                      out, args.in[I_AGKV], args.in[I_ABF], TAB16, (LAS float*)(F.lds + EX_OFF), (LAS unsigned*)(F.lds + LDSCTL_OFF + 16)};
        pg8::gemm_phase<pg8::EpiAin, pg8::StaticOrder, true, true>(F.lds + RING_OFF, g, S, E);
    } SEAM(1);

    if (IN(2)) {
        if (SUB(0) && F.wave == 0) for (int q = F.vcu; q < 192; q += F.G) scan_seq(args, q, F.lane);
        if (SUB(1)) { pg8::Gemm g{(const bf16*)(R + R_QLAT), (const bf16*)(ws + WS_WUQ), MT, NQM, QLORA}; pg8::StaticOrder S; S.init(MT, NQM, F.G, (int)blockIdx.x);
          pg8::EpiQup E{(bf16*)(R + R_QM), (const float*)(R + R_QSSQ), TAB16};
          pg8::gemm_phase<pg8::EpiQup, pg8::StaticOrder, true, true>(F.lds + RING_OFF, g, S, E); }
        if (SUB(2)) { int kk = KVLORA; asm volatile("" : "+s"(kk));
          pg8::Gemm g{(const bf16*)(R + R_CKVB), (const bf16*)(ws + WS_WUKV), MKV, NKV, kk}; pg8::StaticOrder S; S.init(MKV, NKV, F.G, (int)blockIdx.x);
          pg8::EpiKv E{(bf16*)(R + R_KV), NKV};
          pg8::gemm_phase<pg8::EpiKv, pg8::StaticOrder, true, true>(F.lds + RING_OFF, g, S, E); }
    } SEAM(2);

    if (IN(3)) {
        const bf16* QM = (const bf16*)(R + R_QM); const bf16* KV = (const bf16*)(R + R_KV); const bf16* KRB = (const bf16*)(R + R_KRB);
        const bf16* FQ = (const bf16*)(R + R_FQ); const bf16* FK = (const bf16*)(R + R_FK); const bf16* FV = (const bf16*)(R + R_FV);
        const float* CUMP = (const float*)(R + R_CUMP); const float* CUMS = (const float*)(R + R_CUMS);
        if (SUB(0)) for (int set = F.vcu; set < 512; set += F.G) {
            const int bh = set >> 3, s = set & 7, b = bh >> 3, h = bh & 7; const size_t r0 = (size_t)b * SEQ;
            att::ASrc A{QM + r0 * NQM + h * 96, NQM, KV + r0 * NKV + h * 128, NKV, KRB + r0 * 32, 32, KV + r0 * NKV + h * 128 + 64, NKV, nullptr};
            for (int i = 0; i < 4; ++i) { const int qb = (i == 0) ? s : (i == 1) ? 15 - s : (i == 2) ? 16 + s : 31 - s;
                att::f32x16 o[2]; att::attn_unit<0>(A, qb, (char*)lds + RING_OFF, o);
                att::store_o_bf16<64>(o, (char*)lds + RING_OFF, OB + (r0 + (size_t)qb * 256 + F.wave * 32) * DM + h * 64, DM); }
        }
        if (SUB(1)) for (int set = F.vcu; set < 512; set += F.G) {
            const int bh = set >> 3, s = set & 7, b = bh >> 3, h = bh & 7; const size_t r0 = (size_t)b * SEQ;
            att::ASrc A{FQ + r0 * 512 + h * 64, 512, FK + r0 * 512 + h * 64, 512, nullptr, 0, FV + r0 * 512 + h * 64, 512, CUMP + (size_t)bh * SEQ};
            for (int i = 0; i < 4; ++i) { const int qb = (i == 0) ? s : (i == 1) ? 15 - s : (i == 2) ? 16 + s : 31 - s;
                att::f32x16 o[2]; att::attn_unit<1>(A, qb, (char*)lds + RING_OFF, o);
                att::store_o_bf16<64>(o, (char*)lds + RING_OFF, OB + (r0 + (size_t)qb * 256 + F.wave * 32) * DM + 512 + h * 64, DM); }
        }
        char* wl = (char*)lds + RING_OFF + F.wave * 16384; float* wscr = (float*)((char*)lds + SAMP_SCR_OFF) + F.wave * 64;
        if (SUB(2)) for (int u = gw; u < 128 * NSPLIT; u += NGW) {
            const int bh = u / NSPLIT, sp = u % NSPLIT, b = bh >> 3, h = bh & 7; const size_t rq = (size_t)MP + (size_t)b * DSEQ, rk = (size_t)MP + (size_t)b * KVL;
            att::SSrc Sx{QM + rq * NQM + h * 96, NQM, KV + rk * NKV + h * 128, NKV, KRB + rk * 32, 32, KV + rk * NKV + h * 128 + 64, NKV, nullptr, nullptr, 0, nullptr, nullptr, 0, nullptr};
            att::sample_unit<0>(Sx, sp, wl, wscr, (float*)(R + R_PARTM) + (size_t)u * (32 * 66)); }
        if (SUB(3)) for (int u = gw; u < 128 * NSPLIT; u += NGW) {
            const int bh = u / NSPLIT, sp = u % NSPLIT, b = bh >> 3, h = bh & 7; const size_t rq = (size_t)MP + (size_t)b * DSEQ;
            att::SSrc Sx{FQ + rq * 512 + h * 64, 512, nullptr, 0, nullptr, 0, nullptr, 0,
                         args.in[I_CFK] + ((size_t)b * PAST * 8 + h) * 64, out + O_FK_S + ((size_t)b * DSEQ * 8 + h) * 64, 512,
                         args.in[I_CFV] + ((size_t)b * PAST * 8 + h) * 64, out + O_FV_S + ((size_t)b * DSEQ * 8 + h) * 64, 512, CUMS + (size_t)bh * KVL};
            att::sample_unit<1>(Sx, sp, wl, wscr, (float*)(R + R_PARTF) + (size_t)u * (32 * 66)); }
    } SEAM(3);

    if (IN(4)) {
        const int gt = F.vcu * (NWAVES * 64) + F.tid, NGT = F.G * NWAVES * 64;
        for (int it = gt; it < 2 * 128 * 32 * 8; it += NGT) {
            const int ty = it >> 15, r = it & 32767, bh = r >> 8, row = (r >> 3) & 31, ch = r & 7, b = bh >> 3, h = bh & 7;
            const float* P = (const float*)(R + (ty ? R_PARTF : R_PARTM)) + (size_t)bh * NSPLIT * (32 * 66);
            float mmax = -INFINITY;
#pragma unroll
            for (int s = 0; s < NSPLIT; ++s) mmax = fmaxf(mmax, P[s * (32 * 66) + 32 * 64 + row]);
            float L = 0.f; float acc[8] = {0.f, 0.f, 0.f, 0.f, 0.f, 0.f, 0.f, 0.f};
#pragma unroll
            for (int s = 0; s < NSPLIT; ++s) { const float* Ps = P + s * (32 * 66); const float w = __builtin_amdgcn_exp2f(Ps[32 * 64 + row] - mmax); L += Ps[32 * 64 + 32 + row] * w;
                const f32x8 ov = *(const f32x8*)(Ps + row * 64 + ch * 8);
#pragma unroll
                for (int j = 0; j < 8; ++j) acc[j] += ov[j] * w; }
            const float rl = 1.0f / L;
            v4u w4; w4.x = pk2(acc[0] * rl, acc[1] * rl); w4.y = pk2(acc[2] * rl, acc[3] * rl); w4.z = pk2(acc[4] * rl, acc[5] * rl); w4.w = pk2(acc[6] * rl, acc[7] * rl);
            *(v4u*)(OB + ((size_t)MP + (size_t)b * DSEQ + row) * DM + ty * 512 + h * 64 + ch * 8) = w4;
        }
    } SEAM(4);

    if (IN(5)) {
        pg8::Gemm g{OB, (const bf16*)(ws + WS_WAOUT), MT, DM, DM}; pg8::StaticOrder S; S.init(MT, DM, F.G, (int)blockIdx.x);
        pg8::EpiRes E{args.in[I_XP], args.in[I_XS], X, XB, SSQ};
        pg8::gemm_phase<pg8::EpiRes, pg8::StaticOrder, true, true>(F.lds + RING_OFF, g, S, E);
    } SEAM(5);
    if (IN(6)) {
        pg8::Gemm g{XB, (const bf16*)(ws + WS_WUP), MT, DFF, DM}; pg8::StaticOrder S; S.init(MT, DFF, F.G, (int)blockIdx.x);
        pg8::EpiUp E{(bf16*)(R + R_U), SSQ};
        pg8::gemm_phase<pg8::EpiUp, pg8::StaticOrder, true, true>(F.lds + RING_OFF, g, S, E);
    } SEAM(6);
    if (IN(7)) {
        pg8::Gemm g{(const bf16*)(R + R_U), (const bf16*)(ws + WS_WDN), MT, DM, DFF}; pg8::StaticOrder S; S.init(MT, DM, F.G, (int)blockIdx.x);
        pg8::EpiRes E{X, X + (size_t)MP * DM, X, XB, SSQ};
        pg8::gemm_phase<pg8::EpiRes, pg8::StaticOrder, true, true>(F.lds + RING_OFF, g, S, E);
    } SEAM(7);

    if (IN(8)) {
        pg8::Gemm g{XB, (const bf16*)(ws + WS_WCIN), MT, NC, DM}; pg8::StaticOrder S; S.init(MT, NC, F.G, (int)blockIdx.x);
        pg8::EpiCin E{SSQ, (bf16*)(R + R_QC), out, TAB8};
        pg8::gemm_phase<pg8::EpiCin, pg8::StaticOrder, true, true>(F.lds + RING_OFF, g, S, E);
    } SEAM(8);

    if (IN(9)) {
        const bf16* QC = (const bf16*)(R + R_QC); const bf16* KC = (const bf16*)(R + R_KC); const bf16* VC = (const bf16*)(R + R_VC);
        const float lam = diff_lambda(args.in[I_CLAM], F.lane);
        const int r32 = F.lane & 31, hi = F.lane >> 5;
        volatile float* S1 = (volatile float*)(R + R_S1) + ((size_t)blockIdx.x * NWAVES + F.wave) * 4096 + F.lane;
        if (SUB(0)) for (int set = F.vcu; set < 512; set += F.G) {
            const int bh = set >> 3, s = set & 7, b = bh >> 3, h = bh & 7; const size_t r0 = (size_t)b * SEQ;
            for (int i = 0; i < 4; ++i) { const int qb = (i == 0) ? s : (i == 1) ? 15 - s : (i == 2) ? 16 + s : 31 - s;
                att::f32x16 o[4];
#pragma unroll 1
                for (int mp = 0; mp < 2; ++mp) {
                    att::ASrc A{QC + r0 * DM + h * 128 + mp * 64, DM, KC + r0 * DM + h * 128 + mp * 64, DM, nullptr, 0, VC + r0 * DM + h * 128, DM, nullptr};
                    att::attn_unit<2>(A, qb, (char*)lds + RING_OFF, o);
                    if (mp == 0) {
#pragma unroll
                        for (int d = 0; d < 4; ++d) { volatile float* Sd = S1 + d * 1024; asm volatile("" : "+v"(Sd));
#pragma unroll
                            for (int r = 0; r < 16; ++r) Sd[r * 64] = o[d][r]; }
                    }
                }
                VM_WAIT();
                float ss[16];
#pragma unroll
                for (int r = 0; r < 16; ++r) ss[r] = 0.f;
#pragma unroll
                for (int d = 0; d < 4; ++d) { volatile float* Sd = S1 + d * 1024; asm volatile("" : "+v"(Sd));
#pragma unroll
                    for (int r = 0; r < 16; ++r) { const float v = Sd[r * 64] - lam * o[d][r]; o[d][r] = v; ss[r] += v * v; }
                    asm volatile("" ::: "memory"); }
#pragma unroll
                for (int r = 0; r < 16; ++r) { float t = ss[r]; t += __shfl_xor(t, 1); t += __shfl_xor(t, 2); t += __shfl_xor(t, 4); t += __shfl_xor(t, 8); t += __shfl_xor(t, 16);
                    ss[r] = rsqrtf(t * (1.0f / 128.0f) + 1e-5f) * ONE_M_LAM_INIT; }
#pragma unroll
                for (int d = 0; d < 4; ++d) { const float gs = args.in[I_CGSUB][d * 32 + r32];
#pragma unroll
                    for (int r = 0; r < 16; ++r) o[d][r] *= ss[r] * gs; }
                att::store_o_bf16<128>(o, (char*)lds + RING_OFF, OB + (r0 + (size_t)qb * 256 + F.wave * 32) * DM + h * 128, DM);
            }
        }
        char* wl = (char*)lds + RING_OFF + F.wave * 16384; float* wscr = (float*)((char*)lds + SAMP_SCR_OFF) + F.wave * 64;
        if (SUB(2)) for (int u = gw; u < 2 * 128 * NSPLIT; u += NGW) {
            const int mp = u / (128 * NSPLIT), u2 = u % (128 * NSPLIT), bh = u2 / NSPLIT, sp = u2 % NSPLIT, b = bh >> 3, h = bh & 7; const size_t rq = (size_t)MP + (size_t)b * DSEQ;
            att::SSrc Sx{QC + rq * DM + h * 128 + mp * 64, DM, nullptr, 0, nullptr, 0, nullptr, 0,
                         args.in[I_CDK] + ((size_t)b * PAST * 8 + h) * 128 + mp * 64, out + O_DK_S + ((size_t)b * DSEQ * 8 + h) * 128 + mp * 64, 1024,
                         args.in[I_CDV] + ((size_t)b * PAST * 8 + h) * 128, out + O_DV_S + ((size_t)b * DSEQ * 8 + h) * 128, 1024, nullptr};
            att::sample_unit<2>(Sx, sp, wl, wscr, (float*)(R + R_PARTD) + (size_t)u * (32 * 130)); }
        (void)hi;
    } SEAM(9);

    if (IN(10)) {
        const float lam = diff_lambda(args.in[I_CLAM], F.lane);
        const int gt = F.vcu * (NWAVES * 64) + F.tid, NGT = F.G * NWAVES * 64;
        for (int it = gt; it < 128 * 32 * 16; it += NGT) {
            const int bh = it >> 9, row = (it >> 4) & 31, ch = it & 15, b = bh >> 3, h = bh & 7;
            float res[2][8];
#pragma unroll
            for (int mp = 0; mp < 2; ++mp) {
                const float* P = (const float*)(R + R_PARTD) + ((size_t)mp * 128 * NSPLIT + (size_t)bh * NSPLIT) * (32 * 130);
                float mmax = -INFINITY;
#pragma unroll 4
                for (int s = 0; s < NSPLIT; ++s) mmax = fmaxf(mmax, P[s * (32 * 130) + 32 * 128 + row]);
                float L = 0.f; float acc[8] = {0.f, 0.f, 0.f, 0.f, 0.f, 0.f, 0.f, 0.f};
#pragma unroll 2
                for (int s = 0; s < NSPLIT; ++s) { const float* Ps = P + s * (32 * 130); const float w = __builtin_amdgcn_exp2f(Ps[32 * 128 + row] - mmax); L += Ps[32 * 128 + 32 + row] * w;
                    const f32x8 ov = *(const f32x8*)(Ps + row * 128 + ch * 8);
#pragma unroll
                    for (int j = 0; j < 8; ++j) acc[j] += ov[j] * w; }
                const float rl = 1.0f / L;
#pragma unroll
                for (int j = 0; j < 8; ++j) res[mp][j] = acc[j] * rl;
            }
            float v[8]; float ss = 0.f;
#pragma unroll
            for (int j = 0; j < 8; ++j) { v[j] = res[0][j] - lam * res[1][j]; ss += v[j] * v[j]; }
            ss += __shfl_xor(ss, 1); ss += __shfl_xor(ss, 2); ss += __shfl_xor(ss, 4); ss += __shfl_xor(ss, 8);
            const float rs = rsqrtf(ss * (1.0f / 128.0f) + 1e-5f) * ONE_M_LAM_INIT;
            const f32x8 gs = *(const f32x8*)(args.in[I_CGSUB] + ch * 8);
            v4u w4; w4.x = pk2(v[0] * rs * gs[0], v[1] * rs * gs[1]); w4.y = pk2(v[2] * rs * gs[2], v[3] * rs * gs[3]); w4.z = pk2(v[4] * rs * gs[4], v[5] * rs * gs[5]); w4.w = pk2(v[6] * rs * gs[6], v[7] * rs * gs[7]);
            *(v4u*)(OB + ((size_t)MP + (size_t)b * DSEQ + row) * DM + h * 128 + ch * 8) = w4;
        }
    } SEAM(10);

    if (IN(11)) {
        pg8::Gemm g{OB, (const bf16*)(ws + WS_WCOUT), MT, DM, DM}; pg8::StaticOrder S; S.init(MT, DM, F.G, (int)blockIdx.x);
        pg8::EpiRes E{X, X + (size_t)MP * DM, X, XB, SSQ};
        pg8::gemm_phase<pg8::EpiRes, pg8::StaticOrder, true, true>(F.lds + RING_OFF, g, S, E);
    } SEAM(11);
    if (IN(12)) {
        pg8::Gemm g{XB, (const bf16*)(ws + WS_WUP) + (size_t)DFF * DM, MT, DFF, DM}; pg8::StaticOrder S; S.init(MT, DFF, F.G, (int)blockIdx.x);
        pg8::EpiUp E{(bf16*)(R + R_U), SSQ};
        pg8::gemm_phase<pg8::EpiUp, pg8::StaticOrder, true, true>(F.lds + RING_OFF, g, S, E);
    } SEAM(12);
    if (IN(13)) {
        pg8::Gemm g{(const bf16*)(R + R_U), (const bf16*)(ws + WS_WDN) + (size_t)DM * DFF, MT, DM, DFF}; pg8::StaticOrder S; S.init(MT, DM, F.G, (int)blockIdx.x);
        pg8::EpiRes E{X, X + (size_t)MP * DM, X, XB, SSQ};
        pg8::gemm_phase<pg8::EpiRes, pg8::StaticOrder, true, true>(F.lds + RING_OFF, g, S, E);
    } SEAM(13);

    if (IN(14)) {
        const float* gf = args.in[I_GFIN];
        for (int m = gw; m < MT; m += NGW) {
            const f32x4 pv = *(const f32x4*)(SSQ + (size_t)m * 16 + 4 * (F.lane & 3));
            float s = (pv.x + pv.y) + (pv.z + pv.w); s += __shfl_xor(s, 1); s += __shfl_xor(s, 2);
            const float rs = rsqrtf(s * (1.0f / 1024.0f) + 1e-6f);
            GAS f32x4* xr = (GAS f32x4*)(X + (size_t)m * DM) + F.lane; const GAS f32x4* gr = (const GAS f32x4*)gf + F.lane;
#pragma unroll
            for (int j = 0; j < 4; ++j) { const f32x4 v = xr[64 * j] * rs * gr[64 * j]; xr[64 * j] = v; }
        }
    }
#undef IN
#undef SEAM
}


#ifdef MK_PROBE
__global__ void probe_scale(float* out, unsigned mask) {
    const size_t offs[17] = {0, 67108864, O_CKV_P, O_KROPE_P, O_FK_P, O_FV_P, O_LOGF_P, O_DK_P, O_DV_P, O_CKV_S, O_KROPE_S, O_FK_S, O_FV_S, O_LOGF_S, O_DK_S, O_DV_S, O_END};
    for (int t = 0; t < 16; ++t) {
        const bool on = (mask >> t) & 1u;
        for (size_t i = offs[t] + (size_t)blockIdx.x * 256 + threadIdx.x; i < offs[t + 1]; i += (size_t)gridDim.x * 256) out[i] = on ? out[i] * 2.f : 0.f;
    }
}
#endif
extern "C" void kernel_launch(void* const* d_in, const int* in_sizes, int n_in, void* d_out, int out_size, void* d_ws, size_t ws_size, hipStream_t stream) {
    static int grid = 0;
    if (grid == 0) {
        if (n_in != 25 || in_sizes[0] != MP * DM || (size_t)out_size != O_END || ws_size < WS_END) {
            fprintf(stderr, "kernel_launch: shape mismatch: n_in %d in0 %d out %d ws %zu (need %zu)\n", n_in, n_in > 0 ? in_sizes[0] : -1, out_size, ws_size, (size_t)WS_END); grid = -1; return; }
        int dev = 0, cus = 0;
        if (hipGetDevice(&dev) != hipSuccess || hipDeviceGetAttribute(&cus, hipDeviceAttributeMultiprocessorCount, dev) != hipSuccess) { grid = -1; return; }
        if (hipFuncSetAttribute((const void*)mk_fwd, hipFuncAttributeMaxDynamicSharedMemorySize, LDS_BYTES) != hipSuccess) { fprintf(stderr, "kernel_launch: hipFuncSetAttribute failed\n"); grid = -1; return; }
        int per_cu = 0;
        if (hipOccupancyMaxActiveBlocksPerMultiprocessor(&per_cu, (const void*)mk_fwd, NWAVES * 64, LDS_BYTES) != hipSuccess || per_cu < 1)
            fprintf(stderr, "kernel_launch: occupancy query reports %d workgroups per CU\n", per_cu);
        (void)hipGetLastError();
        grid = cus;
    }
    if (grid < 0) return;
    if (hipMemsetAsync((char*)d_ws + WS_CTL, 0, CTL_BYTES, stream) != hipSuccess) return;
    Args a{};
    for (int i = 0; i < 25; ++i) a.in[i] = (const float*)d_in[i];
    a.out = (float*)d_out; a.ws = (unsigned char*)d_ws;
#if MK_PER_PHASE
    for (int p = 0; p < MK_PH_END; ++p) { a.ph_lo = p; a.ph_hi = p + 1; a.use_bar = 0; hipLaunchKernelGGL(mk_fwd, dim3(grid), dim3(NWAVES * 64), LDS_BYTES, stream, a); }
#else
    a.ph_lo = 0; a.ph_hi = MK_PH_END; a.use_bar = 1;
    hipLaunchKernelGGL(mk_fwd, dim3(grid), dim3(NWAVES * 64), LDS_BYTES, stream, a);
#endif
#ifdef MK_PROBE
    hipLaunchKernelGGL(probe_scale, dim3(2048), dim3(256), 0, stream, (float*)d_out, (unsigned)MK_PROBE);
#endif
    const hipError_t le = hipPeekAtLastError();
    if (le != hipSuccess) fprintf(stderr, "kernel_launch: launch failed: %s\n", hipGetErrorName(le));
}
```

```cpp
#include <hip/hip_runtime.h>
#include <hip/hip_bf16.h>
#include <cstdio>
#include <cstdint>

constexpr int DM = 1024, NBP = 8, SEQ = 8192, NBS = 16, DSEQ = 32, PAST = 4096, KVL = PAST + DSEQ;
constexpr int MP = NBP * SEQ, MS = NBS * DSEQ, MT = MP + MS;
constexpr int MKV = MP + NBS * KVL;
constexpr int A_IN = 2344, NA = 2560, QLORA = 512, KVLORA = 256, NQM = 768, NKV = 1024, DFF = 4096, NC = 3072;
constexpr float C2M = 0.14724444602590306f;
constexpr float C2F = 0.18033688011112042f;
constexpr float LOG2E = 1.4426950408889634f;
constexpr float LAM_INIT = 0.35550906759096934f, ONE_M_LAM_INIT = 0.6444909324090307f;
constexpr int NSPLIT = 16;

constexpr size_t O_Y = 0;
constexpr size_t O_CKV_P = 67633152, O_KROPE_P = 84410368, O_FK_P = 86507520, O_FV_P = 120061952, O_LOGF_P = 153616384;
constexpr size_t O_DK_P = 154140672, O_DV_P = 221249536;
constexpr size_t O_CKV_S = 288358400, O_KROPE_S = 288489472, O_FK_S = 288505856, O_FV_S = 288768000, O_LOGF_S = 289030144;
constexpr size_t O_DK_S = 289034240, O_DV_S = 289558528, O_END = 290082816;

constexpr size_t al256(size_t x) { return (x + 255) / 256 * 256; }
constexpr size_t WS_CTL = 0, CTL_BYTES = 1u << 20;
constexpr size_t WS_TAB16 = WS_CTL + CTL_BYTES;
constexpr size_t WS_TAB8 = WS_TAB16 + (size_t)8192 * 32 * 4;
constexpr size_t WS_WAIN = WS_TAB8 + (size_t)8192 * 16 * 4;
constexpr size_t WS_WUQ = WS_WAIN + (size_t)NA * DM * 2;
constexpr size_t WS_WUKV = WS_WUQ + (size_t)NQM * QLORA * 2;
constexpr size_t WS_WAOUT = WS_WUKV + (size_t)NKV * KVLORA * 2;
constexpr size_t WS_WUP = WS_WAOUT + (size_t)DM * DM * 2;
constexpr size_t WS_WDN = WS_WUP + (size_t)2 * DFF * DM * 2;
constexpr size_t WS_WCIN = WS_WDN + (size_t)2 * DM * DFF * 2;
constexpr size_t WS_WCOUT = WS_WCIN + (size_t)NC * DM * 2;
constexpr size_t WS_XB = WS_WCOUT + (size_t)DM * DM * 2;
constexpr size_t WS_SSQ = WS_XB + (size_t)MT * DM * 2;
constexpr size_t WS_R = al256(WS_SSQ + (size_t)MT * 16 * 4);
constexpr size_t R_QLAT = 0;
constexpr size_t R_QSSQ = R_QLAT + (size_t)MT * QLORA * 2;
constexpr size_t R_CKVB = R_QSSQ + (size_t)MT * 8 * 4;
constexpr size_t R_KRB = R_CKVB + (size_t)MKV * KVLORA * 2;
constexpr size_t R_FQ = R_KRB + (size_t)MKV * 32 * 2;
constexpr size_t R_FK = R_FQ + (size_t)MT * 512 * 2;
constexpr size_t R_FV = R_FK + (size_t)MP * 512 * 2;
constexpr size_t R_CUMP = R_FV + (size_t)MP * 512 * 2;
constexpr size_t R_CUMS = R_CUMP + (size_t)64 * SEQ * 4;
constexpr size_t R_QM = al256(R_CUMS + (size_t)128 * KVL * 4);
constexpr size_t R_KV = R_QM + (size_t)MT * NQM * 2;
constexpr size_t R_O = R_KV + (size_t)MKV * NKV * 2;
constexpr size_t R_PARTM = R_O + (size_t)MT * DM * 2;
constexpr size_t R_PARTF = R_PARTM + (size_t)2048 * 32 * 66 * 4;
constexpr size_t R_END0 = R_PARTF + (size_t)2048 * 32 * 66 * 4;
constexpr size_t R_QC = 0;
constexpr size_t R_KC = R_QC + (size_t)MT * DM * 2;
constexpr size_t R_VC = R_KC + (size_t)MP * DM * 2;
constexpr size_t R_PARTD = R_O + (size_t)MT * DM * 2;
constexpr size_t R_S1 = R_PARTD + (size_t)4096 * 32 * 130 * 4;
constexpr size_t R_END1 = R_S1 + (size_t)256 * 8 * 64 * 64 * 4;
constexpr size_t R_U = 0;
constexpr size_t R_ENDU = (size_t)MT * DFF * 2;
constexpr size_t R_SIZE = R_END0 > R_END1 ? (R_END0 > R_ENDU ? R_END0 : R_ENDU) : (R_END1 > R_ENDU ? R_END1 : R_ENDU);
constexpr size_t WS_END = WS_R + R_SIZE;
static_assert(R_VC + (size_t)MP * DM * 2 <= R_O && R_KC == R_QC + (size_t)MT * DM * 2 && R_VC == R_KC + (size_t)MP * DM * 2, "layer-1 q | k | v consecutive, below O");
static_assert(WS_END <= (size_t)1200 * 1024 * 1024, "d_ws budget");
static_assert(WS_R + R_ENDU + (size_t)MT * DM * 6 + (size_t)MT * 64 <= (size_t)1200 * 1024 * 1024, "probe scratch above U");

constexpr int CW_TMO = 0, CW_CODE = 1, CW_BAR = 4096;

constexpr int RING_OFF = 0, RING_BYTES = 131072;
constexpr int EX_OFF = RING_BYTES;
constexpr int SAMP_SCR_OFF = EX_OFF + 4096;
constexpr int LDSCTL_OFF = SAMP_SCR_OFF + 2048;
constexpr int LDS_BYTES = 147456;
static_assert(LDSCTL_OFF + 256 <= LDS_BYTES, "LDS map");

__device__ const float ROPE16_HI[16] = {1.591549367e-01f, 7.008652389e-02f, 3.086376376e-02f, 1.359137055e-02f, 5.985185504e-03f, 2.635675715e-03f, 1.160663669e-03f, 5.111175124e-04f,
                                        2.250790858e-04f, 9.911730012e-05f, 4.364795313e-05f, 1.922110096e-05f, 8.464330676e-06f, 3.727408739e-06f, 1.641426365e-06f, 7.228293271e-07f};
__device__ const float ROPE16_LO[16] = {6.420638243e-09f, -3.367168766e-09f, -6.060805191e-10f, 3.539428195e-10f, 1.724232701e-10f, 1.458525488e-11f, -4.802871642e-11f, -2.710419215e-11f,
                                        -6.753226017e-12f, 2.390691378e-12f, 1.677238209e-12f, -6.428835329e-13f, 4.522939098e-13f, -1.846790678e-14f, 2.120927809e-14f, -2.060453045e-14f};
__device__ const float ROPE8_HI[8] = {1.591549367e-01f, 3.086376376e-02f, 5.985185504e-03f, 1.160663669e-03f, 2.250790858e-04f, 4.364795313e-05f, 8.464330676e-06f, 1.641426365e-06f};
__device__ const float ROPE8_LO[8] = {6.420638243e-09f, -6.060805191e-10f, 1.724232701e-10f, -4.802871642e-11f, -6.753226017e-12f, 1.677238209e-12f, 4.522939098e-13f, 2.120927809e-14f};

namespace pg8 {
#define PG8_LAS __attribute__((address_space(3)))
typedef unsigned short bf16_t;
typedef short bf16x8 __attribute__((ext_vector_type(8)));
typedef float f32x4 __attribute__((ext_vector_type(4)));
typedef unsigned u32x4 __attribute__((ext_vector_type(4)));
constexpr int BM = 256, BK = 64, HALF = 128, HTB = HALF * BK * 2  , STAGE_BYTES = 8 * HTB, NXCD = 8, WGM = 8;

__host__ __device__ __forceinline__ int lds_byte(int r, int c) { const int st = (r >> 4) * 2 + (c >> 5), rr = r & 15, cc = c & 31, ob = rr * 64 + cc * 2; return st * 1024 + (ob ^ (((ob >> 9) & 1) << 5)); }
__host__ __device__ __forceinline__ void stage_rc(int b, int& R, int& C) { const int st = b / 1024, sb = b % 1024, swz = sb ^ (((sb >> 9) & 1) << 5); R = (st >> 1) * 16 + swz / 64; C = (st & 1) * 32 + (swz % 64) / 2; }
__host__ __device__ __forceinline__ int perm32(int rho) { const int n = rho >> 4, i = rho & 15; return 8 * (i >> 2) + 4 * n + (i & 3); }

struct Unit { int pm, pn; };
struct Gemm { const bf16_t* A; const bf16_t* Bt; int M, N, K; };

struct StaticOrder {
    int nM, nN, nwg, G, c;
    __host__ __device__ void init(int M, int N, int G_, int c_) { nM = M / BM; nN = N / BM; nwg = nM * nN; G = G_; c = c_; }
    __host__ __device__ bool next(int i, Unit& u) const {
        const long L = (long)i * G + c; if (L >= nwg) return false;
        int wgid = (int)L; { const int q = nwg / NXCD, r = nwg % NXCD, xcd = wgid % NXCD, off = wgid / NXCD; wgid = (xcd < r ? xcd * (q + 1) : r * (q + 1) + (xcd - r) * q) + off; }
        const int nig = WGM * nN, gid = wgid / nig, fm = gid * WGM, gsz = (nM - fm) < WGM ? (nM - fm) : WGM;
        u.pm = fm + ((wgid % nig) % gsz); u.pn = (wgid % nig) / gsz; return true;
    }
    __device__ __forceinline__ void a_ready(const Unit&) const {}
    __device__ __forceinline__ void done(const Unit&) const {}
};

__device__ __forceinline__ unsigned cvt_pk_bf16(float lo, float hi) { unsigned r; asm volatile("v_cvt_pk_bf16_f32 %0, %1, %2" : "=v"(r) : "v"(lo), "v"(hi)); return r; }
typedef float f32x2 __attribute__((ext_vector_type(2)));
typedef unsigned u32x2 __attribute__((ext_vector_type(2)));
__device__ __forceinline__ u32x2 pk4(f32x4 v) { u32x2 w; w.x = cvt_pk_bf16(v[0], v[1]); w.y = cvt_pk_bf16(v[2], v[3]); return w; }
__device__ __forceinline__ float dot4(f32x4 v) { return (v[0] * v[0] + v[1] * v[1]) + (v[2] * v[2] + v[3] * v[3]); }
__device__ __forceinline__ float row_rstd16(const float* ssq, int row, int fq) {
    const f32x4 v = *(const f32x4*)(ssq + (size_t)row * 16 + 4 * fq);
    float s = (v[0] + v[1]) + (v[2] + v[3]);
    s += __shfl_xor(s, 16); s += __shfl_xor(s, 32);
    return rsqrtf(s * (1.0f / 1024.0f) + 1e-6f);
}
__device__ __forceinline__ float log_sigmoid_f(float z) {
    const float e = __expf(-fabsf(z));
    const float l1p = (e < 1e-3f) ? e * (1.f - 0.5f * e + e * e * (1.f / 3.f)) : __logf(1.f + e);
    return fminf(z, 0.f) - l1p;
}

struct EpiRes {
    static constexpr bool PERM = false, AFTER_DRAIN = false;
    const float* basep; const float* bases;
    float* X; bf16_t* XB; float* ssq;
    __device__ __forceinline__ void operator()(const f32x4 (&acc)[2][2][4][2], const Unit& u, int wr, int wc, int fr, int fq) const {
        const int row0 = u.pm * BM + wr * 64 + fr, col0 = u.pn * BM + wc * 32 + 4 * fq;
        const float* bb = (u.pm >= 256) ? (bases - (size_t)MP * DM) : basep;
#pragma unroll
        for (int ai = 0; ai < 2; ++ai)
#pragma unroll
            for (int m = 0; m < 4; ++m) {
                const int row = row0 + ai * HALF + m * 16; const size_t off = (size_t)row * DM + col0; float ss = 0.f;
#pragma unroll
                for (int bj = 0; bj < 2; ++bj)
#pragma unroll
                    for (int n = 0; n < 2; ++n) {
                        const f32x4 x = *(const f32x4*)(bb + off + bj * HALF + n * 16) + acc[ai][bj][m][n];
                        *(f32x4*)(X + off + bj * HALF + n * 16) = x; *(u32x2*)(XB + off + bj * HALF + n * 16) = pk4(x); ss += dot4(x); }
                ss += __shfl_xor(ss, 16); ss += __shfl_xor(ss, 32);
                if (fq == 0) ssq[(size_t)row * 16 + u.pn * 4 + wc] = ss;
            }
    }
};

struct EpiUp {
    static constexpr bool PERM = true, AFTER_DRAIN = false;
    bf16_t* U; const float* ssq;
    __device__ __forceinline__ void operator()(const f32x4 (&acc)[2][2][4][2], const Unit& u, int wr, int wc, int fr, int fq) const {
        const int row0 = u.pm * BM + wr * 64 + fr, col0 = u.pn * BM + wc * 32 + 8 * fq;
#pragma unroll
        for (int ai = 0; ai < 2; ++ai)
#pragma unroll
            for (int m = 0; m < 4; ++m) {
                const int row = row0 + ai * HALF + m * 16; const float rs = row_rstd16(ssq, row, fq);
                bf16_t* rowp = U + (size_t)row * DFF + col0;
#pragma unroll
                for (int bj = 0; bj < 2; ++bj) {
                    f32x4 v0 = acc[ai][bj][m][0] * rs, v1 = acc[ai][bj][m][1] * rs;
#pragma unroll
                    for (int j = 0; j < 4; ++j) { const float a = fmaxf(v0[j], 0.f), b = fmaxf(v1[j], 0.f); v0[j] = a * a; v1[j] = b * b; }
                    u32x4 w; w.x = cvt_pk_bf16(v0[0], v0[1]); w.y = cvt_pk_bf16(v0[2], v0[3]); w.z = cvt_pk_bf16(v1[0], v1[1]); w.w = cvt_pk_bf16(v1[2], v1[3]);
                    *(u32x4*)(rowp + bj * HALF) = w; }
            }
    }
};

struct EpiKv {
    static constexpr bool PERM = true, AFTER_DRAIN = false;
    bf16_t* O; int ldc;
    __device__ __forceinline__ void operator()(const f32x4 (&acc)[2][2][4][2], const Unit& u, int wr, int wc, int fr, int fq) const {
        const int row0 = u.pm * BM + wr * 64 + fr, col0 = u.pn * BM + wc * 32 + 8 * fq;
#pragma unroll
        for (int ai = 0; ai < 2; ++ai)
#pragma unroll
            for (int m = 0; m < 4; ++m) { bf16_t* rowp = O + (size_t)(row0 + ai * HALF + m * 16) * ldc + col0;
#pragma unroll
                for (int bj = 0; bj < 2; ++bj) { const f32x4 v0 = acc[ai][bj][m][0], v1 = acc[ai][bj][m][1];
                    u32x4 w; w.x = cvt_pk_bf16(v0[0], v0[1]); w.y = cvt_pk_bf16(v0[2], v0[3]); w.z = cvt_pk_bf16(v1[0], v1[1]); w.w = cvt_pk_bf16(v1[2], v1[3]);
                    *(u32x4*)(rowp + bj * HALF) = w; } }
    }
};

struct EpiQup {
    static constexpr bool PERM = false, AFTER_DRAIN = false;
    bf16_t* QM; const float* qssq; const float* tab16;
    __device__ __forceinline__ void operator()(const f32x4 (&acc)[2][2][4][2], const Unit& u, int wr, int wc, int fr, int fq) const {
        const int row0 = u.pm * BM + wr * 64 + fr, col0 = u.pn * BM + wc * 32 + 4 * fq;
#pragma unroll
        for (int ai = 0; ai < 2; ++ai)
#pragma unroll
            for (int m = 0; m < 4; ++m) {
                const int row = row0 + ai * HALF + m * 16;
                const f32x4 s0 = *(const f32x4*)(qssq + (size_t)row * 8), s1 = *(const f32x4*)(qssq + (size_t)row * 8 + 4);
                const float ssum = ((s0[0] + s0[1]) + (s0[2] + s0[3])) + ((s1[0] + s1[1]) + (s1[2] + s1[3]));
                const float rs = rsqrtf(ssum * (1.0f / 512.0f) + 1e-6f) * C2M;
                const int pos = (row >= MP) ? (PAST + ((row - MP) & 31)) : (row & (SEQ - 1));
                const f32x4 cs = *(const f32x4*)(tab16 + (size_t)pos * 32 + 4 * fq), sn = *(const f32x4*)(tab16 + (size_t)pos * 32 + 16 + 4 * fq);
                bf16_t* rowp = QM + (size_t)row * NQM + col0;
#pragma unroll
                for (int bj = 0; bj < 2; ++bj) {
                    const int g = u.pn * 8 + bj * 4 + wc;
                    f32x4 x1 = acc[ai][bj][m][0] * rs, x2 = acc[ai][bj][m][1] * rs;
                    if (g % 3 == 2) { const f32x4 r1 = x1 * cs - x2 * sn, r2 = x2 * cs + x1 * sn; x1 = r1; x2 = r2; }
                    *(u32x2*)(rowp + bj * HALF) = pk4(x1); *(u32x2*)(rowp + bj * HALF + 16) = pk4(x2); }
            }
    }
};

struct EpiAin {
    static constexpr bool PERM = false, AFTER_DRAIN = false;
    const float* ssq; bf16_t* QLAT; float* QSSQ; bf16_t* CKVB; bf16_t* KRB; bf16_t* FQ; bf16_t* FK; bf16_t* FV;
    float* out;
    const float* g_kv; const float* b_f; const float* tab16;
    PG8_LAS float* ex; PG8_LAS unsigned* excnt;
    __device__ __forceinline__ void operator()(const f32x4 (&acc)[2][2][4][2], const Unit& u, int wr, int wc, int fr, int fq) const {
        const int row0 = u.pm * BM + wr * 64 + fr, cl0 = wc * 32 + 4 * fq;
        const bool samp = u.pm >= 256;
        const int pn = u.pn;
#define RSV(ai, m) row_rstd16(ssq, row0 + (ai) * HALF + (m) * 16, fq)
        if (pn < 2) {
#pragma unroll
            for (int ai = 0; ai < 2; ++ai)
#pragma unroll
                for (int m = 0; m < 4; ++m) { const int row = row0 + ai * HALF + m * 16; float ss = 0.f; bf16_t* rowp = QLAT + (size_t)row * QLORA + pn * 256 + cl0; const float rsv = RSV(ai, m);
#pragma unroll
                    for (int bj = 0; bj < 2; ++bj)
#pragma unroll
                        for (int n = 0; n < 2; ++n) { const f32x4 v = acc[ai][bj][m][n] * rsv; ss += dot4(v); *(u32x2*)(rowp + bj * HALF + n * 16) = pk4(v); }
                    ss += __shfl_xor(ss, 16); ss += __shfl_xor(ss, 32);
                    if (fq == 0) QSSQ[(size_t)row * 8 + pn * 4 + wc] = ss; }
        } else if (pn == 2) {
            PG8_LAS float* exh = ex + wr * 512;
#pragma unroll
            for (int ai = 0; ai < 2; ++ai)
#pragma unroll
                for (int m = 0; m < 4; ++m) { float ss = 0.f; const float rsv = RSV(ai, m);
#pragma unroll
                    for (int bj = 0; bj < 2; ++bj)
#pragma unroll
                        for (int n = 0; n < 2; ++n) { const f32x4 v = acc[ai][bj][m][n] * rsv; ss += dot4(v); }
                    ss += __shfl_xor(ss, 16); ss += __shfl_xor(ss, 32);
                    if (fq == 0) exh[(ai * 64 + m * 16 + fr) * 4 + wc] = ss; }
            asm volatile("s_waitcnt lgkmcnt(0)" ::: "memory");
            unsigned old = 0u;
            if (fr == 0 && fq == 0) old = __hip_atomic_fetch_add(excnt + wr, 1u, __ATOMIC_RELAXED, __HIP_MEMORY_SCOPE_WORKGROUP);
            const unsigned target = ((unsigned)__builtin_amdgcn_readfirstlane((int)old) / 4u + 1u) * 4u;
            { unsigned sp = 0; while (__hip_atomic_load(excnt + wr, __ATOMIC_RELAXED, __HIP_MEMORY_SCOPE_WORKGROUP) < target) { __builtin_amdgcn_s_sleep(1); if (++sp > (1u << 22)) break; } }
            asm volatile("s_waitcnt lgkmcnt(0)" ::: "memory");
#pragma unroll
            for (int ai = 0; ai < 2; ++ai)
#pragma unroll
                for (int m = 0; m < 4; ++m) { const int row = row0 + ai * HALF + m * 16;
                    const f32x4 t = *(const PG8_LAS f32x4*)(exh + (ai * 64 + m * 16 + fr) * 4);
                    const float rc = rsqrtf(((t[0] + t[1]) + (t[2] + t[3])) * (1.0f / 256.0f) + 1e-6f) * RSV(ai, m);
                    const int srow = row - MP;
                    const size_t orow = samp ? (O_CKV_S + (size_t)srow * 256) : (O_CKV_P + (size_t)row * 256);
                    const size_t brow = samp ? ((size_t)MP + (size_t)(srow >> 5) * KVL + PAST + (srow & 31)) : (size_t)row;
#pragma unroll
                    for (int bj = 0; bj < 2; ++bj)
#pragma unroll
                        for (int n = 0; n < 2; ++n) { const int c = cl0 + bj * HALF + n * 16; const f32x4 v = acc[ai][bj][m][n] * rc * *(const f32x4*)(g_kv + c);
                            *(f32x4*)(out + orow + c) = v; *(u32x2*)(CKVB + brow * KVLORA + c) = pk4(v); } }
        } else if (pn < 5) {
#pragma unroll
            for (int ai = 0; ai < 2; ++ai)
#pragma unroll
                for (int m = 0; m < 4; ++m) { const int row = row0 + ai * HALF + m * 16; bf16_t* rowp = FQ + (size_t)row * 512 + (pn - 3) * 256 + cl0; const float s = RSV(ai, m) * C2F;
#pragma unroll
                    for (int bj = 0; bj < 2; ++bj)
#pragma unroll
                        for (int n = 0; n < 2; ++n) *(u32x2*)(rowp + bj * HALF + n * 16) = pk4(acc[ai][bj][m][n] * s); }
        } else if (pn < 9) {
            const bool isk = pn < 7; const int ct = (isk ? pn - 5 : pn - 7) * 256 + cl0;
            bf16_t* B = isk ? FK : FV;
            const size_t obase = samp ? (isk ? O_FK_S : O_FV_S) : (isk ? O_FK_P : O_FV_P);
#pragma unroll
            for (int ai = 0; ai < 2; ++ai)
#pragma unroll
                for (int m = 0; m < 4; ++m) { const int row = row0 + ai * HALF + m * 16; const int orow = samp ? row - MP : row; const float rsv = RSV(ai, m);
#pragma unroll
                    for (int bj = 0; bj < 2; ++bj)
#pragma unroll
                        for (int n = 0; n < 2; ++n) { const f32x4 v = acc[ai][bj][m][n] * rsv; const int c = ct + bj * HALF + n * 16;
                            *(f32x4*)(out + obase + (size_t)orow * 512 + c) = v; if (!samp) *(u32x2*)(B + (size_t)row * 512 + c) = pk4(v); } }
        } else {
            if (wc == 0) {
#pragma unroll
                for (int ai = 0; ai < 2; ++ai)
#pragma unroll
                    for (int m = 0; m < 4; ++m) { const int row = row0 + ai * HALF + m * 16; const int srow = row - MP;
                        const int pos = samp ? (PAST + (srow & 31)) : (row & (SEQ - 1));
                        const f32x4 cs = *(const f32x4*)(tab16 + (size_t)pos * 32 + 4 * fq), sn = *(const f32x4*)(tab16 + (size_t)pos * 32 + 16 + 4 * fq);
                        const float rsv = RSV(ai, m); const f32x4 x1 = acc[ai][0][m][0] * rsv, x2 = acc[ai][0][m][1] * rsv;
                        const f32x4 r1 = x1 * cs - x2 * sn, r2 = x2 * cs + x1 * sn;
                        const size_t orow = samp ? (O_KROPE_S + (size_t)srow * 32) : (O_KROPE_P + (size_t)row * 32);
                        const size_t brow = samp ? ((size_t)MP + (size_t)(srow >> 5) * KVL + PAST + (srow & 31)) : (size_t)row;
                        *(f32x4*)(out + orow + 4 * fq) = r1; *(f32x4*)(out + orow + 16 + 4 * fq) = r2;
                        *(u32x2*)(KRB + brow * 32 + 4 * fq) = pk4(r1); *(u32x2*)(KRB + brow * 32 + 16 + 4 * fq) = pk4(r2); }
            } else if (wc == 1) {
                const f32x4 bf = *(const f32x4*)(b_f + 4 * (fq & 1));
#pragma unroll
                for (int ai = 0; ai < 2; ++ai)
#pragma unroll
                    for (int m = 0; m < 4; ++m) { const int row = row0 + ai * HALF + m * 16;
                        const float rsv = RSV(ai, m);
                        const f32x4 z = acc[ai][0][m][0] * rsv + bf; f32x4 lf;
#pragma unroll
                        for (int j = 0; j < 4; ++j) lf[j] = log_sigmoid_f(z[j]);
                        const size_t orow = samp ? (O_LOGF_S + (size_t)(row - MP) * 8) : (O_LOGF_P + (size_t)row * 8);
                        if (fq < 2) *(f32x4*)(out + orow + 4 * fq) = lf; }
            }
        }
#undef RSV
    }
};

struct EpiCin {
    static constexpr bool PERM = false, AFTER_DRAIN = false;
    const float* ssq; bf16_t* QC; float* out; const float* tab8;
    __device__ __forceinline__ void operator()(const f32x4 (&acc)[2][2][4][2], const Unit& u, int wr, int wc, int fr, int fq) const {
        const int row0 = u.pm * BM + wr * 64 + fr, cl0 = wc * 32 + 4 * fq;
        const bool samp = u.pm >= 256; const int pn = u.pn; const int kind = pn >> 2;
        const int ct = (pn & 3) * 256 + cl0;
        const bool rot = (kind < 2) && ((wc & 1) == 0);
        const size_t obase = (samp ? O_DK_S : O_DK_P) + (size_t)(kind == 2) * (samp ? (O_DV_S - O_DK_S) : (O_DV_P - O_DK_P));
        bf16_t* B = QC + (size_t)(kind >= 1) * ((size_t)MT * DM) + (size_t)(kind >= 2) * ((size_t)MP * DM);
#pragma unroll
        for (int ai = 0; ai < 2; ++ai)
#pragma unroll
            for (int m = 0; m < 4; ++m) { const int row = row0 + ai * HALF + m * 16; const int srow = row - MP; const int orow = samp ? srow : row;
                const float rsv = row_rstd16(ssq, row, fq);
                const int pos = samp ? (PAST + (srow & 31)) : (row & (SEQ - 1));
                const f32x4 cs = *(const f32x4*)(tab8 + (size_t)pos * 16 + 4 * (fq & 1)), sn = *(const f32x4*)(tab8 + (size_t)pos * 16 + 8 + 4 * (fq & 1));
#pragma unroll
                for (int bj = 0; bj < 2; ++bj)
#pragma unroll
                    for (int n = 0; n < 2; ++n) { f32x4 v = acc[ai][bj][m][n] * rsv; const int c = ct + bj * HALF + n * 16;
                        if (n == 0 && kind < 2) {
                            f32x4 p;
#pragma unroll
                            for (int j = 0; j < 4; ++j) p[j] = __shfl_xor(v[j], 32);
                            if (rot) v = (fq < 2) ? (v * cs - p * sn) : (v * cs + p * sn);
                        }
                        if (kind == 0) v = v * C2F;
                        if (kind != 0) *(f32x4*)(out + obase + (size_t)orow * DM + c) = v;
                        if (kind == 0 || !samp) *(u32x2*)(B + (size_t)row * DM + c) = pk4(v); } }
    }
};
template <class Epi, class Sched, bool ALIGN_EPI = false, bool SP2 = false>
__device__ __forceinline__ void gemm_phase(PG8_LAS unsigned char* lds, const Gemm g, const Sched& S, const Epi& E) {
    const int tid = threadIdx.x, wid = __builtin_amdgcn_readfirstlane(tid >> 6), lane = tid & 63, wr = wid >> 2, wc = wid & 3, fr = lane & 15, fq = lane >> 4;
    const int K = g.K, nt = K / BK;
    unsigned voffA[2], voffB[2];
#pragma unroll
    for (int i = 0; i < 2; ++i) { int R, C; stage_rc(tid * 16 + i * 8192, R, C); const int Rb = Epi::PERM ? ((R & ~31) + perm32(R & 31)) : R;
        voffA[i] = (unsigned)(R * K + C) * 2u; voffB[i] = (unsigned)(Rb * K + C) * 2u; }
    const size_t kstep = (size_t)(BK * 2);
    const size_t hstep = (size_t)HALF * K * 2;
    const size_t tstep = 2 * hstep;
    const unsigned ldsw = (unsigned)wid * 1024u;
    const int aoff = lds_byte(wr * 64 + fr, fq * 8), boff = lds_byte(wc * 32 + fr, fq * 8);
#define PG8_SA(b, h) (((b) * 2 + (h)) * HTB)
#define PG8_SB(b, h) ((4 + (b) * 2 + (h)) * HTB)
#define PG8_STAGE(bufoff, gbase, voff) do { _Pragma("unroll") for (int _i = 0; _i < 2; ++_i) \
        __builtin_amdgcn_global_load_lds((const unsigned*)((const char*)(gbase) + (voff)[_i]), (PG8_LAS unsigned*)(lds + (bufoff) + ldsw + _i * 8192), 16, 0, 0); } while (0)
#define PG8_LDA(dst, b, h) do { _Pragma("unroll") for (int m = 0; m < 4; ++m) _Pragma("unroll") for (int k = 0; k < 2; ++k) dst[m][k] = *(const PG8_LAS bf16x8*)(lds + PG8_SA(b, h) + aoff + m * 2048 + k * 1024); } while (0)
#define PG8_LDB(dst, b, h) do { _Pragma("unroll") for (int n = 0; n < 2; ++n) _Pragma("unroll") for (int k = 0; k < 2; ++k) dst[n][k] = *(const PG8_LAS bf16x8*)(lds + PG8_SB(b, h) + boff + n * 2048 + k * 1024); } while (0)
#define PG8_MMA(ai, bj, At, Bt) do { __builtin_amdgcn_s_setprio(1); _Pragma("unroll") for (int m = 0; m < 4; ++m) _Pragma("unroll") for (int n = 0; n < 2; ++n) _Pragma("unroll") for (int k = 0; k < 2; ++k) \
        acc[ai][bj][m][n] = __builtin_amdgcn_mfma_f32_16x16x32_bf16(Bt[n][k], At[m][k], acc[ai][bj][m][n], 0, 0, 0); __builtin_amdgcn_s_setprio(0); } while (0)
#define PG8_WAIT_V(n) asm volatile("s_waitcnt vmcnt(" #n ")" ::: "memory")
#define PG8_WAIT_L(n) asm volatile("s_waitcnt lgkmcnt(" #n ")" ::: "memory")
#define PG8_BAR __builtin_amdgcn_s_barrier()
#define PG8_SCHED __builtin_amdgcn_sched_barrier(0)
    Unit cur, nxt; int ui = 0;
    if (!S.next(0, cur)) return;
    f32x4 acc[2][2][4][2];
#pragma unroll
    for (int a = 0; a < 2; ++a)
#pragma unroll
        for (int b = 0; b < 2; ++b)
#pragma unroll
            for (int m = 0; m < 4; ++m)
#pragma unroll
                for (int n = 0; n < 2; ++n) acc[a][b][m][n] = (f32x4){0.f, 0.f, 0.f, 0.f};
    bf16x8 At[4][2], B0[2][2], B1[2][2];
    const char* cA = (const char*)g.A + (size_t)cur.pm * tstep; const char* cB = (const char*)g.Bt + (size_t)cur.pn * tstep;
    S.a_ready(cur);
    if constexpr (SP2) {
        PG8_STAGE(PG8_SB(0, 0), cB, voffB); PG8_STAGE(PG8_SB(0, 1), cB + hstep, voffB); PG8_STAGE(PG8_SA(0, 0), cA, voffA); PG8_STAGE(PG8_SA(0, 1), cA + hstep, voffA);
        if (wr == 1) PG8_BAR;
        PG8_WAIT_V(2); PG8_BAR;
        PG8_STAGE(PG8_SB(1, 0), cB + kstep, voffB); PG8_STAGE(PG8_SA(1, 0), cA + kstep, voffA); PG8_STAGE(PG8_SB(1, 1), cB + hstep + kstep, voffB);
        PG8_WAIT_V(6); PG8_BAR;
    } else {
        PG8_STAGE(PG8_SB(0, 0), cB, voffB); PG8_STAGE(PG8_SA(0, 0), cA, voffA); PG8_STAGE(PG8_SB(0, 1), cB + hstep, voffB); PG8_STAGE(PG8_SA(0, 1), cA + hstep, voffA);
        if (wr == 1) PG8_BAR;
        PG8_WAIT_V(4); PG8_BAR;
        PG8_STAGE(PG8_SB(1, 0), cB + kstep, voffB); PG8_STAGE(PG8_SA(1, 0), cA + kstep, voffA); PG8_STAGE(PG8_SB(1, 1), cB + hstep + kstep, voffB);
        PG8_WAIT_V(6); PG8_BAR;
    }
    for (;;) {
        const bool has_next = S.next(ui + 1, nxt);
        const char* nA = has_next ? (const char*)g.A + (size_t)nxt.pm * tstep : cA; const char* nB = has_next ? (const char*)g.Bt + (size_t)nxt.pn * tstep : cB;
        for (int t = 0; t < nt; t += 2) {
            const bool last = (t == nt - 2);
            const char* a1 = cA + (size_t)(t + 1) * kstep;
            const char* a2 = last ? nA : cA + (size_t)(t + 2) * kstep; const char* b2 = last ? nB : cB + (size_t)(t + 2) * kstep;
            const char* a3 = a2 + kstep; const char* b3 = b2 + kstep;
            if (last && has_next) S.a_ready(nxt);
            if constexpr (SP2) {
            PG8_LDB(B0, 0, 0); PG8_LDB(B1, 0, 1); PG8_SCHED; PG8_LDA(At, 0, 0); PG8_STAGE(PG8_SA(1, 1), a1 + hstep, voffA);
            PG8_WAIT_V(8); PG8_WAIT_L(0); PG8_BAR; PG8_MMA(0, 0, At, B0); PG8_MMA(0, 1, At, B1); PG8_BAR; PG8_SCHED;
            PG8_LDA(At, 0, 1); PG8_STAGE(PG8_SB(0, 0), b2, voffB); PG8_STAGE(PG8_SB(0, 1), b2 + hstep, voffB); PG8_STAGE(PG8_SA(0, 0), a2, voffA);
            PG8_WAIT_V(8); PG8_WAIT_L(0); PG8_BAR; PG8_MMA(1, 0, At, B0); PG8_MMA(1, 1, At, B1); PG8_BAR; PG8_SCHED;
            PG8_LDB(B0, 1, 0); PG8_LDB(B1, 1, 1); PG8_SCHED; PG8_LDA(At, 1, 0); PG8_STAGE(PG8_SA(0, 1), a2 + hstep, voffA);
            PG8_WAIT_V(8); PG8_WAIT_L(0); PG8_BAR; PG8_MMA(0, 0, At, B0); PG8_MMA(0, 1, At, B1); PG8_BAR; PG8_SCHED;
            PG8_LDA(At, 1, 1); PG8_STAGE(PG8_SB(1, 0), b3, voffB); PG8_STAGE(PG8_SB(1, 1), b3 + hstep, voffB); PG8_STAGE(PG8_SA(1, 0), a3, voffA);
            PG8_WAIT_V(8); PG8_WAIT_L(0); PG8_BAR; PG8_MMA(1, 0, At, B0); PG8_MMA(1, 1, At, B1); PG8_BAR; PG8_SCHED;
            } else {
            PG8_LDB(B0, 0, 0); PG8_SCHED; PG8_LDA(At, 0, 0); PG8_STAGE(PG8_SA(1, 1), a1 + hstep, voffA);
            PG8_WAIT_L(8); PG8_BAR; PG8_WAIT_L(0); PG8_MMA(0, 0, At, B0); PG8_BAR; PG8_SCHED;
            PG8_LDB(B1, 0, 1); PG8_STAGE(PG8_SB(0, 0), b2, voffB);
            PG8_BAR; PG8_WAIT_L(0); PG8_MMA(0, 1, At, B1); PG8_BAR;
            PG8_LDA(At, 0, 1); PG8_STAGE(PG8_SA(0, 0), a2, voffA);
            PG8_BAR; PG8_WAIT_L(0); PG8_MMA(1, 0, At, B0); PG8_BAR; PG8_SCHED;
            PG8_STAGE(PG8_SB(0, 1), b2 + hstep, voffB);
            PG8_WAIT_V(6); PG8_BAR; PG8_MMA(1, 1, At, B1); PG8_BAR;
            PG8_LDB(B0, 1, 0); PG8_SCHED; PG8_LDA(At, 1, 0); PG8_STAGE(PG8_SA(0, 1), a2 + hstep, voffA);
            PG8_WAIT_L(8); PG8_BAR; PG8_WAIT_L(0); PG8_MMA(0, 0, At, B0); PG8_BAR; PG8_SCHED;
            PG8_LDB(B1, 1, 1); PG8_STAGE(PG8_SB(1, 0), b3, voffB);
            PG8_BAR; PG8_WAIT_L(0); PG8_MMA(0, 1, At, B1); PG8_BAR;
            PG8_LDA(At, 1, 1); PG8_STAGE(PG8_SA(1, 0), a3, voffA);
            PG8_BAR; PG8_WAIT_L(0); PG8_MMA(1, 0, At, B0); PG8_BAR; PG8_SCHED;
            PG8_STAGE(PG8_SB(1, 1), b3 + hstep, voffB);
            PG8_WAIT_V(6); PG8_BAR; PG8_MMA(1, 1, At, B1); PG8_BAR;
            }
        }
        if constexpr (ALIGN_EPI) { if (wr == 0) PG8_BAR; }
        if constexpr (!Epi::AFTER_DRAIN) { E(acc, cur, wr, wc, fr, fq); S.done(cur); }
        if (!has_next) break;
#pragma unroll
        for (int a = 0; a < 2; ++a)
#pragma unroll
            for (int b = 0; b < 2; ++b)
#pragma unroll
                for (int m = 0; m < 4; ++m)
#pragma unroll
                    for (int n = 0; n < 2; ++n) acc[a][b][m][n] = (f32x4){0.f, 0.f, 0.f, 0.f};
        cur = nxt; cA = nA; cB = nB; ++ui;
        if constexpr (ALIGN_EPI) { if (wr == 1) PG8_BAR; }
    }
    PG8_WAIT_V(0);
    if constexpr (!ALIGN_EPI) { if (wr == 0) PG8_BAR; }
    PG8_BAR;
    if constexpr (Epi::AFTER_DRAIN) { E.fused(acc, cur, wr, wc, fr, fq, lds, wid, lane); S.done(cur); }
#undef PG8_SA
#undef PG8_SB
#undef PG8_STAGE
#undef PG8_LDA
#undef PG8_LDB
#undef PG8_MMA
#undef PG8_WAIT_V
#undef PG8_WAIT_L
#undef PG8_BAR
#undef PG8_SCHED
}
}
namespace att {
using bf16 = unsigned short;
using bf16x8 = __attribute__((ext_vector_type(8))) short;
using s16x4 = __attribute__((ext_vector_type(4))) short;
using f32x16 = __attribute__((ext_vector_type(16))) float;
using f32x8 = __attribute__((ext_vector_type(8))) float;
using f32x4 = __attribute__((ext_vector_type(4))) float;
using u32x4 = __attribute__((ext_vector_type(4))) unsigned;
#define SBAR() __builtin_amdgcn_sched_barrier(0)
constexpr float THRL = 6.0f;
__device__ __forceinline__ int crow(int r, int hi) { return (r & 3) + 8 * (r >> 2) + 4 * hi; }
__device__ __forceinline__ unsigned cvtpk(float lo, float hi) { unsigned r; asm volatile("v_cvt_pk_bf16_f32 %0, %1, %2" : "=v"(r) : "v"(lo), "v"(hi)); return r; }
__device__ __forceinline__ bf16x8 f8_to_bf(f32x8 x) { u32x4 w = {cvtpk(x[0], x[1]), cvtpk(x[2], x[3]), cvtpk(x[4], x[5]), cvtpk(x[6], x[7])}; return __builtin_bit_cast(bf16x8, w); }
template <int DQK> __device__ __forceinline__ int kswz(int row, int c) {
    if constexpr (DQK == 64) return row * 128 + ((c ^ ((row >> 1) & 7)) << 4);
    else return row * 192 + ((c ^ ((row >> 2) & 3)) << 4);
}
template <int NCB> __device__ __forceinline__ int v_st(int k, int c) { const int kk = (k & ~0xC) | ((k & 4) << 1) | ((k & 8) >> 1); return ((kk >> 3) * NCB + (c >> 5)) * 512 + ((kk & 7) * 32 + (c & 31)) * 2; }
__device__ __forceinline__ int v_rd_base(int lane) { return ((lane & 3) << 3) | (((lane >> 2) & 3) << 6) | (((lane >> 4) & 1) << 5) | (((lane >> 5) & 1) << 8); }
template <int OFF> __device__ __forceinline__ s16x4 tr_read(int vb) { s16x4 r; asm volatile("ds_read_b64_tr_b16 %0, %1 offset:%2" : "=&v"(r) : "v"(vb), "i"(OFF) : "memory"); return r; }
template <int NCB, int D0> __device__ __forceinline__ void pv_one(f32x16& od, int vb, bf16x8 pa0, bf16x8 pa1, bf16x8 pa2, bf16x8 pa3) {
    constexpr int KS = NCB * 1024, HF = NCB * 512, B0 = D0 * 512;
    const s16x4 l0 = tr_read<B0>(vb), h0 = tr_read<B0 + HF>(vb), l1 = tr_read<B0 + KS>(vb), h1 = tr_read<B0 + KS + HF>(vb);
    const s16x4 l2 = tr_read<B0 + 2 * KS>(vb), h2 = tr_read<B0 + 2 * KS + HF>(vb), l3 = tr_read<B0 + 3 * KS>(vb), h3 = tr_read<B0 + 3 * KS + HF>(vb);
    asm volatile("s_waitcnt lgkmcnt(0)" ::: "memory"); SBAR();
#define PK(L, H) (bf16x8){L[0], L[1], L[2], L[3], H[0], H[1], H[2], H[3]}
    od = __builtin_amdgcn_mfma_f32_32x32x16_bf16(pa0, PK(l0, h0), od, 0, 0, 0);
    od = __builtin_amdgcn_mfma_f32_32x32x16_bf16(pa1, PK(l1, h1), od, 0, 0, 0);
    od = __builtin_amdgcn_mfma_f32_32x32x16_bf16(pa2, PK(l2, h2), od, 0, 0, 0);
    od = __builtin_amdgcn_mfma_f32_32x32x16_bf16(pa3, PK(l3, h3), od, 0, 0, 0);
#undef PK
}
template <int NCB> __device__ __forceinline__ void pv_all(f32x16* o, int vb, bf16x8 pa0, bf16x8 pa1, bf16x8 pa2, bf16x8 pa3) {
    pv_one<NCB, 0>(o[0], vb, pa0, pa1, pa2, pa3); pv_one<NCB, 1>(o[1], vb, pa0, pa1, pa2, pa3);
    if constexpr (NCB == 4) { pv_one<NCB, 2>(o[2], vb, pa0, pa1, pa2, pa3); pv_one<NCB, 3>(o[3], vb, pa0, pa1, pa2, pa3); }
}
__device__ __forceinline__ void partialSM(f32x16& p0, f32x16& p1, float& m_reg, float& alpha) {
    float pmax = p0[0];
#pragma unroll
    for (int r = 1; r < 16; ++r) pmax = fmaxf(pmax, p0[r]);
#pragma unroll
    for (int r = 0; r < 16; ++r) pmax = fmaxf(pmax, p1[r]);
    { auto rr = __builtin_amdgcn_permlane32_swap(__float_as_uint(pmax), __float_as_uint(pmax), false, false); pmax = fmaxf(__uint_as_float(rr[0]), __uint_as_float(rr[1])); }
    float mn;
    if (__builtin_expect(__all(pmax - m_reg <= THRL), 1)) { mn = m_reg; alpha = 1.f; }
    else { mn = fmaxf(m_reg, pmax); alpha = __builtin_amdgcn_exp2f(m_reg - mn); m_reg = mn; }
#pragma unroll
    for (int r = 0; r < 16; ++r) { p0[r] -= mn; p1[r] -= mn; }
#pragma unroll
    for (int r = 0; r < 16; ++r) p0[r] = __builtin_amdgcn_exp2f(p0[r]);
}
__device__ __forceinline__ void finishSM(f32x16& p0, f32x16& p1, float alpha, float& l_reg, bf16x8& pa0, bf16x8& pa1, bf16x8& pa2, bf16x8& pa3) {
#pragma unroll
    for (int r = 0; r < 16; ++r) p1[r] = __builtin_amdgcn_exp2f(p1[r]);
    float ps = 0;
#pragma unroll
    for (int r = 0; r < 16; ++r) ps += p0[r];
#pragma unroll
    for (int r = 0; r < 16; ++r) ps += p1[r];
    { auto rr = __builtin_amdgcn_permlane32_swap(__float_as_uint(ps), __float_as_uint(ps), false, false); ps = __uint_as_float(rr[0]) + __uint_as_float(rr[1]); }
    l_reg = l_reg * alpha + ps;
#define PK4(P, BASE, OUT) do { unsigned a0 = cvtpk(P[BASE + 0], P[BASE + 1]), a1 = cvtpk(P[BASE + 2], P[BASE + 3]);   \
    unsigned b0 = cvtpk(P[BASE + 4], P[BASE + 5]), b1 = cvtpk(P[BASE + 6], P[BASE + 7]);                              \
    auto r0 = __builtin_amdgcn_permlane32_swap(a0, b0, false, false); auto r1 = __builtin_amdgcn_permlane32_swap(a1, b1, false, false); \
    u32x4 w = {r0[0], r1[0], r0[1], r1[1]}; OUT = __builtin_bit_cast(bf16x8, w); } while (0)
    PK4(p0, 0, pa0); PK4(p0, 8, pa1); PK4(p1, 0, pa2); PK4(p1, 8, pa3);
#undef PK4
}

template <int TYPE> struct ALds;
template <int TYPE> struct ATraits;
template <> struct ATraits<0> { static constexpr int DQK = 96, DV = 64; };
template <> struct ATraits<1> { static constexpr int DQK = 64, DV = 64; };
template <> struct ATraits<2> { static constexpr int DQK = 64, DV = 128; };
template <int TYPE> struct ALds { static constexpr int VB = 64 * ATraits<TYPE>::DV * 2, KB = 64 * ATraits<TYPE>::DQK * 2, L_V = 0, L_K = 2 * VB, L_CK = L_K + 2 * KB, L_WS = L_CK + 512, L_OST = L_WS + 2048, L_END = L_OST + 8 * 8192; };
struct ASrc {
    const bf16* q; int ldq;
    const bf16* k0; int ldk0;
    const bf16* k1; int ldk1;
    const bf16* v; int ldv;
    const float* ck;
};
template <int TYPE>
__device__ __forceinline__ void attn_unit(const ASrc& S, int qb, char* lds, f32x16 (&o)[ATraits<TYPE>::DV / 32]) {
    constexpr int DQK = ATraits<TYPE>::DQK, DV = ATraits<TYPE>::DV, NCB = DV / 32, ND0 = DQK / 16, KCH = DQK / 8, VCH = DV / 8;
    constexpr int KB = 64 * DQK * 2, VB = 64 * DV * 2;
    int tid_ = threadIdx.x; asm volatile("" : "+v"(tid_));
    const int tid = tid_, lane = tid & 63, r32 = lane & 31, hi = lane >> 5; const int wid = __builtin_amdgcn_readfirstlane(tid >> 6);
    char* V_lds = lds + ALds<TYPE>::L_V; char* K_lds = lds + ALds<TYPE>::L_K; float* CK_lds = (float*)(lds + ALds<TYPE>::L_CK);
    float* ws = (float*)(lds + ALds<TYPE>::L_WS) + wid * 64; float* li_l = ws; float* al_l = ws + 32;
    static_assert(ALds<TYPE>::L_END <= SAMP_SCR_OFF, "attention LDS map (may run over the idle ckv-exchange words, not beyond)");
    float m_reg = -1e30f, l_reg = 0.f; bf16x8 qr[ND0];
#pragma unroll
    for (int d = 0; d < NCB; ++d) o[d] = f32x16{};
    { const bf16* Qw = S.q + (size_t)(qb * 256 + wid * 32 + r32) * S.ldq + hi * 8;
#pragma unroll
      for (int d0 = 0; d0 < ND0; ++d0) qr[d0] = *reinterpret_cast<const bf16x8*>(Qw + d0 * 16); }
    const int NT = 4 * qb + 4, Lw = 4 * qb + (wid >> 1);
    const int vb0 = (int)(uintptr_t)V_lds + v_rd_base(lane);
    constexpr int NVI = (64 * VCH) / 512;
    bf16x8 ksr0[2], ksr1[2], vsr[2][NVI]; f32x4 cksr[2];
    const int krow = tid >> 3, kc = tid & 7, k1row = (tid >> 2) & 63, k1c = tid & 3;
    const unsigned koff0 = (unsigned)(krow * S.ldk0 + kc * 8), koff1 = (unsigned)(k1row * S.ldk1 + k1c * 8);
    unsigned voff[NVI]; int vlds[NVI];
#pragma unroll
    for (int i = 0; i < NVI; ++i) { const int id = tid + i * 512, row = id / VCH, c = id % VCH; voff[i] = (unsigned)(row * S.ldv + c * 8); vlds[i] = v_st<NCB>(row, c * 8); }
    const int klds0 = kswz<DQK>(krow, kc), klds1 = (TYPE == 0) ? kswz<DQK>(k1row, 8 + k1c) : 0;
#define SLOAD(st, t) do { const size_t k0_ = (size_t)(t) * 64;                                                                 \
    ksr0[st] = *reinterpret_cast<const bf16x8*>(S.k0 + k0_ * S.ldk0 + koff0);                                                   \
    if (TYPE == 0 && tid < 256) ksr1[st] = *reinterpret_cast<const bf16x8*>(S.k1 + k0_ * S.ldk1 + koff1);                       \
    _Pragma("unroll") for (int i_ = 0; i_ < NVI; ++i_) vsr[st][i_] = *reinterpret_cast<const bf16x8*>(S.v + k0_ * S.ldv + voff[i_]); \
    if (TYPE == 1 && tid < 16) cksr[st] = *reinterpret_cast<const f32x4*>(S.ck + k0_ + tid * 4); } while (0)
#define SWRITE(st, b) do {                                                                                                      \
    *reinterpret_cast<bf16x8*>(K_lds + (b) * KB + klds0) = ksr0[st];                                                            \
    if (TYPE == 0 && tid < 256) *reinterpret_cast<bf16x8*>(K_lds + (b) * KB + klds1) = ksr1[st];                                \
    if (TYPE == 1 && tid < 16) *reinterpret_cast<f32x4*>(CK_lds + (b) * 64 + tid * 4) = cksr[st];                               \
    _Pragma("unroll") for (int i_ = 0; i_ < NVI; ++i_) *reinterpret_cast<bf16x8*>(V_lds + (b) * VB + vlds[i_]) = vsr[st][i_]; } while (0)
#define QKT(P0, P1, b) do { const char* Kb_ = K_lds + (b) * KB;                                                                                   \
    if (TYPE == 1) { const float* ck_ = CK_lds + (b) * 64 + 4 * hi;                                                                                \
        _Pragma("unroll") for (int g_ = 0; g_ < 4; ++g_) { const f32x4 a_ = *reinterpret_cast<const f32x4*>(ck_ + 8 * g_), b_ = *reinterpret_cast<const f32x4*>(ck_ + 32 + 8 * g_); \
            _Pragma("unroll") for (int j_ = 0; j_ < 4; ++j_) { P0[4 * g_ + j_] = a_[j_]; P1[4 * g_ + j_] = b_[j_]; } } }                          \
    else { P0 = f32x16{}; P1 = f32x16{}; }                                                                                                         \
    _Pragma("unroll") for (int d0_ = 0; d0_ < ND0; ++d0_) {                                                                                        \
        const bf16x8 b0_ = *reinterpret_cast<const bf16x8*>(Kb_ + kswz<DQK>(r32, 2 * d0_ + hi));                                                   \
        const bf16x8 b1_ = *reinterpret_cast<const bf16x8*>(Kb_ + 32 * (DQK * 2) + kswz<DQK>(r32, 2 * d0_ + hi));                                  \
        P0 = __builtin_amdgcn_mfma_f32_32x32x16_bf16(b0_, qr[d0_], P0, 0, 0, 0);                                                                   \
        P1 = __builtin_amdgcn_mfma_f32_32x32x16_bf16(b1_, qr[d0_], P1, 0, 0, 0); } } while (0)
#define DIAGMASK(P0, P1) do { const int rin_ = 32 * (wid & 1) + r32;                                                                              \
    _Pragma("unroll") for (int r_ = 0; r_ < 16; ++r_) { const int c_ = crow(r_, hi); if (c_ > rin_) P0[r_] = -INFINITY; if (c_ + 32 > rin_) P1[r_] = -INFINITY; } } while (0)
#define RESC(a) do { if (__any((a) < 1.f)) { if (hi == 0) al_l[r32] = (a); asm volatile("s_waitcnt lgkmcnt(0)" ::: "memory");                      \
    _Pragma("unroll") for (int d_ = 0; d_ < NCB; ++d_) _Pragma("unroll") for (int r_ = 0; r_ < 16; ++r_) o[d_][r_] *= al_l[crow(r_, hi)]; } } while (0)
    f32x16 p0, p1; float alpha = 1.f; bf16x8 pa0, pa1, pa2, pa3;
#define TILE(j) do { if ((j) <= Lw) { QKT(p0, p1, (j) & 1); if (TYPE == 1 && (j) == Lw) DIAGMASK(p0, p1); partialSM(p0, p1, m_reg, alpha); RESC(alpha);      \
        finishSM(p0, p1, alpha, l_reg, pa0, pa1, pa2, pa3); SBAR(); pv_all<NCB>(o, vb0 + ((j) & 1) * VB, pa0, pa1, pa2, pa3); } } while (0)
    SLOAD(0, 0); SWRITE(0, 0); SLOAD(1, 1); __syncthreads();
    for (int j = 0; j < NT; j += 2) {
        if (j + 2 < NT) SLOAD(0, j + 2);
        SBAR(); TILE(j); SBAR();
        SWRITE(1, 1);
        __syncthreads();
        if (j + 3 < NT) SLOAD(1, j + 3);
        SBAR(); TILE(j + 1); SBAR();
        if (j + 2 < NT) SWRITE(0, 0);
        __syncthreads();
    }
#undef TILE
    if (hi == 0) li_l[r32] = l_reg; asm volatile("s_waitcnt lgkmcnt(0)" ::: "memory");
#pragma unroll
    for (int r = 0; r < 16; ++r) { const float rl = __builtin_amdgcn_rcpf(li_l[crow(r, hi)]);
#pragma unroll
        for (int d = 0; d < NCB; ++d) o[d][r] *= rl; }
#undef SLOAD
#undef SWRITE
#undef QKT
#undef DIAGMASK
#undef RESC
}
template <int DV>
__device__ __forceinline__ void store_o_bf16(const f32x16 (&o)[DV / 32], char* stage0  , bf16* Ow  , int ldo) {
    int tid_ = threadIdx.x; asm volatile("" : "+v"(tid_));
    const int lane = tid_ & 63, r32 = lane & 31, hi = lane >> 5; const int wid = __builtin_amdgcn_readfirstlane(tid_ >> 6);
    __hip_bfloat16* stg = (__hip_bfloat16*)(stage0 + wid * 8192);
#pragma unroll
    for (int r = 0; r < 16; ++r) { const int orow = crow(r, hi);
#pragma unroll
        for (int d = 0; d < DV / 32; ++d) stg[orow * DV + d * 32 + r32] = __float2bfloat16(o[d][r]); }
    asm volatile("s_waitcnt lgkmcnt(0)" ::: "memory");
    constexpr int CPR = DV / 8, RPI = 64 / CPR;
#pragma unroll
    for (int i = 0; i < 32 / RPI; ++i) { const int row = i * RPI + lane / CPR, ch = lane % CPR;
        const u32x4 v = *(const u32x4*)((const char*)stg + (row * DV + ch * 8) * 2); *(u32x4*)(Ow + (size_t)row * ldo + ch * 8) = v; }
    asm volatile("s_waitcnt lgkmcnt(0)" ::: "memory");
}

struct SSrc {
    const bf16* q; int ldq;
    const bf16* k0; int ldk0; const bf16* k1; int ldk1; const bf16* vb; int ldvb;
    const float* kc; const float* kn; int ldkf; const float* vc; const float* vn; int ldvf;
    const float* ck;
};
template <int TYPE>
__device__ __forceinline__ void sample_unit(const SSrc& S, int split, char* wlds  , float* wscr  , float* part) {
    constexpr int DQK = ATraits<TYPE>::DQK, DV = ATraits<TYPE>::DV, NCB = DV / 32, ND0 = DQK / 16, VCH = DV / 8;
    const int lane = threadIdx.x & 63, r32 = lane & 31, hi = lane >> 5;
    bf16x8 qr[ND0]; f32x16 o[NCB]; float m_reg = -1e30f, l_reg = 0.f;
#pragma unroll
    for (int d = 0; d < NCB; ++d) o[d] = f32x16{};
    { const bf16* Qw = S.q + (size_t)r32 * S.ldq + hi * 8;
#pragma unroll
      for (int d0 = 0; d0 < ND0; ++d0) qr[d0] = *reinterpret_cast<const bf16x8*>(Qw + d0 * 16); }
    const int vb0 = (int)(uintptr_t)wlds + v_rd_base(lane);
    const int ntile = (split == NSPLIT - 1) ? 5 : 4;
    for (int t = 0; t < ntile; ++t) {
        const bool newt = (t == 4); const int key0 = newt ? PAST : split * 256 + t * 64;
        f32x16 p0, p1;
        if constexpr (TYPE == 1) { const float* ck = S.ck + key0 + 4 * hi;
#pragma unroll
            for (int g = 0; g < 4; ++g) { const f32x4 a = *reinterpret_cast<const f32x4*>(ck + 8 * g); f32x4 b = a; if (!newt) b = *reinterpret_cast<const f32x4*>(ck + 32 + 8 * g);
#pragma unroll
                for (int j = 0; j < 4; ++j) { p0[4 * g + j] = a[j]; p1[4 * g + j] = b[j]; } } }
        else { p0 = f32x16{}; p1 = f32x16{}; }
#pragma unroll
        for (int d0 = 0; d0 < ND0; ++d0) {
            bf16x8 b0, b1; const int col = d0 * 16 + hi * 8;
            const int ka = key0 + r32, kb = newt ? key0 + r32 : key0 + 32 + r32;
            if constexpr (TYPE == 0) {
                if (d0 < 4) { b0 = *reinterpret_cast<const bf16x8*>(S.k0 + (size_t)ka * S.ldk0 + col); b1 = *reinterpret_cast<const bf16x8*>(S.k0 + (size_t)kb * S.ldk0 + col); }
                else { b0 = *reinterpret_cast<const bf16x8*>(S.k1 + (size_t)ka * S.ldk1 + col - 64); b1 = *reinterpret_cast<const bf16x8*>(S.k1 + (size_t)kb * S.ldk1 + col - 64); }
            } else {
                const float* pa = newt ? (S.kn + (size_t)(ka - PAST) * S.ldkf) : (S.kc + (size_t)ka * S.ldkf);
                const float* pb = newt ? (S.kn + (size_t)(kb - PAST) * S.ldkf) : (S.kc + (size_t)kb * S.ldkf);
                b0 = f8_to_bf(*reinterpret_cast<const f32x8*>(pa + col)); b1 = f8_to_bf(*reinterpret_cast<const f32x8*>(pb + col));
            }
            p0 = __builtin_amdgcn_mfma_f32_32x32x16_bf16(b0, qr[d0], p0, 0, 0, 0);
            p1 = __builtin_amdgcn_mfma_f32_32x32x16_bf16(b1, qr[d0], p1, 0, 0, 0);
        }
        if (newt) {
#pragma unroll
            for (int r = 0; r < 16; ++r) { p1[r] = -INFINITY; if (TYPE == 1 && crow(r, hi) > r32) p0[r] = -INFINITY; }
        }
#pragma unroll
        for (int i = 0; i < VCH; ++i) { const int id = lane + i * 64, row = id / VCH, c = id % VCH; int kk = key0 + row; if (newt) kk = key0 + (row & 31);
            bf16x8 vv;
            if constexpr (TYPE == 0) vv = *reinterpret_cast<const bf16x8*>(S.vb + (size_t)kk * S.ldvb + c * 8);
            else { const float* pv = newt ? (S.vn + (size_t)(kk - PAST) * S.ldvf) : (S.vc + (size_t)kk * S.ldvf); vv = f8_to_bf(*reinterpret_cast<const f32x8*>(pv + c * 8)); }
            *reinterpret_cast<bf16x8*>(wlds + v_st<NCB>(row, c * 8)) = vv; }
        float pmax = p0[0];
#pragma unroll
        for (int r = 1; r < 16; ++r) pmax = fmaxf(pmax, p0[r]);
#pragma unroll
        for (int r = 0; r < 16; ++r) pmax = fmaxf(pmax, p1[r]);
        { auto rr = __builtin_amdgcn_permlane32_swap(__float_as_uint(pmax), __float_as_uint(pmax), false, false); pmax = fmaxf(__uint_as_float(rr[0]), __uint_as_float(rr[1])); }
        const float mn = fmaxf(m_reg, pmax), alpha = __builtin_amdgcn_exp2f(m_reg - mn); m_reg = mn;
#pragma unroll
        for (int r = 0; r < 16; ++r) { p0[r] = __builtin_amdgcn_exp2f(p0[r] - mn); p1[r] = __builtin_amdgcn_exp2f(p1[r] - mn); }
        float ps = 0.f;
#pragma unroll
        for (int r = 0; r < 16; ++r) ps += p0[r] + p1[r];
        { auto rr = __builtin_amdgcn_permlane32_swap(__float_as_uint(ps), __float_as_uint(ps), false, false); ps = __uint_as_float(rr[0]) + __uint_as_float(rr[1]); }
        l_reg = l_reg * alpha + ps;
        if (hi == 0) wscr[r32] = alpha; asm volatile("s_waitcnt lgkmcnt(0)" ::: "memory");
#pragma unroll
        for (int d = 0; d < NCB; ++d)
#pragma unroll
            for (int r = 0; r < 16; ++r) o[d][r] *= wscr[crow(r, hi)];
        bf16x8 pa0, pa1, pa2, pa3;
#define PK4(P, BASE, OUT) do { unsigned a0 = cvtpk(P[BASE + 0], P[BASE + 1]), a1 = cvtpk(P[BASE + 2], P[BASE + 3]);   \
    unsigned b0 = cvtpk(P[BASE + 4], P[BASE + 5]), b1 = cvtpk(P[BASE + 6], P[BASE + 7]);                              \
    auto r0 = __builtin_amdgcn_permlane32_swap(a0, b0, false, false); auto r1 = __builtin_amdgcn_permlane32_swap(a1, b1, false, false); \
    u32x4 w = {r0[0], r1[0], r0[1], r1[1]}; OUT = __builtin_bit_cast(bf16x8, w); } while (0)
        PK4(p0, 0, pa0); PK4(p0, 8, pa1); PK4(p1, 0, pa2); PK4(p1, 8, pa3);
#undef PK4
        asm volatile("s_waitcnt lgkmcnt(0)" ::: "memory"); SBAR();
        pv_all<NCB>(o, vb0, pa0, pa1, pa2, pa3);
        asm volatile("s_waitcnt lgkmcnt(0)" ::: "memory"); SBAR();
    }
#pragma unroll
    for (int r = 0; r < 16; ++r) { const int orow = crow(r, hi);
#pragma unroll
        for (int d = 0; d < NCB; ++d) part[orow * DV + d * 32 + r32] = o[d][r]; }
    if (hi == 0) { part[32 * DV + r32] = m_reg; part[32 * DV + 32 + r32] = l_reg; }
}
#undef SBAR
}
constexpr int NWAVES = 8;
#define GAS __attribute__((address_space(1)))
#define LAS __attribute__((address_space(3)))
typedef unsigned short bf16;
typedef unsigned v4u __attribute__((ext_vector_type(4)));
typedef unsigned v2u __attribute__((ext_vector_type(2)));
typedef float f32x4 __attribute__((ext_vector_type(4)));
typedef float f32x8 __attribute__((ext_vector_type(8)));
typedef short bf16x8 __attribute__((ext_vector_type(8)));
typedef GAS unsigned gu32;
#define RLX_AGENT __ATOMIC_RELAXED, __HIP_MEMORY_SCOPE_AGENT
#define LDS_WAIT() asm volatile("s_waitcnt lgkmcnt(0)" ::: "memory")
#define VM_WAIT() asm volatile("s_waitcnt vmcnt(0)" ::: "memory")
__device__ __forceinline__ unsigned pk2(float lo, float hi) { unsigned r; asm volatile("v_cvt_pk_bf16_f32 %0, %1, %2" : "=v"(r) : "v"(lo), "v"(hi)); return r; }
__device__ __forceinline__ float bf2f(unsigned short b) { return __uint_as_float((unsigned)b << 16); }

#define XB_TMO      128
#define XB_XCNT(j)  (256  + 64 * (j))
#define XB_XSUB(j)  (1280 + 64 * (j))
#define XB_XGEN(j)  (2304 + 64 * (j))
#define XB_TOP      3328
#define XB_TOPGEN   3392
#define XCD_BAR_WORDS 3456
#define XB_SPIN_CAP (1u << 22)

__device__ __forceinline__ unsigned xb_ld(unsigned* p)              { return __hip_atomic_load(p, __ATOMIC_RELAXED, __HIP_MEMORY_SCOPE_AGENT); }
__device__ __forceinline__ unsigned xb_add(unsigned* p, unsigned v) { return __hip_atomic_fetch_add(p, v, __ATOMIC_RELAXED, __HIP_MEMORY_SCOPE_AGENT); }
__device__ __forceinline__ unsigned xb_xcc_id() { return (unsigned)__builtin_amdgcn_s_getreg((3 << 11) | 20) & 0xFu; }
#define XB_SPIN(cond, bar) do { unsigned _sp = 0; while (cond) { __builtin_amdgcn_s_sleep(1); \
    if ((++_sp & 255u) == 0u) { if (xb_ld(&(bar)[XB_TMO])) break; if (_sp > XB_SPIN_CAP) { atomicAdd(&(bar)[XB_TMO], 1u); break; } } } } while (0)

struct XcdBarrier {
    unsigned* bar; unsigned x;
    volatile LAS unsigned* st;
};

__device__ __forceinline__ XcdBarrier xcd_barrier_post(unsigned* bar, volatile LAS unsigned* st) {
    XcdBarrier b; b.bar = bar; b.x = xb_xcc_id(); b.st = st;
    if (threadIdx.x == 0) (void)xb_add(&bar[XB_XCNT(b.x)], 1u);
    return b;
}
__device__ __forceinline__ void xcd_barrier_complete(unsigned* bar, unsigned x, unsigned& nloc, unsigned& nx) {
    const unsigned G = gridDim.x * gridDim.y * gridDim.z;
    unsigned sum, cnt, mine, sp = 0u;
    for (;;) {
        sum = 0u; cnt = 0u; mine = 0u;
#pragma unroll
        for (unsigned j = 0; j < 16; ++j) { const unsigned c = xb_ld(&bar[XB_XCNT(j)]); sum += c; cnt += (c > 0u) ? 1u : 0u; mine = (j == x) ? c : mine; }
        if (sum == G) break;
        __builtin_amdgcn_s_sleep(1);
        if ((++sp & 255u) == 0u) { if (xb_ld(&bar[XB_TMO])) break; if (sp > XB_SPIN_CAP) { atomicAdd(&bar[XB_TMO], 1u); break; } }
    }
    nloc = mine > 0u ? mine : 1u; nx = cnt > 0u ? cnt : 1u;
}

__device__ __forceinline__ void xcd_barrier(const XcdBarrier& b) {
    asm volatile("s_waitcnt vmcnt(0)" ::: "memory");
    __syncthreads();
    if (threadIdx.x == 0) {
        unsigned* bar = b.bar;
        __builtin_amdgcn_s_waitcnt(0);
        unsigned nloc = b.st[0], nx = b.st[1];
        if (nloc == 0u) { xcd_barrier_complete(bar, b.x, nloc, nx); b.st[0] = nloc; b.st[1] = nx; }
        const unsigned old = xb_add(&bar[XB_XSUB(b.x)], 1u);
        const unsigned gen = old / nloc;
        if (old + 1u == (gen + 1u) * nloc) {
            __builtin_amdgcn_fence(__ATOMIC_RELEASE, "agent");
            asm volatile("s_waitcnt vmcnt(0)" ::: "memory");
            const unsigned og = xb_add(&bar[XB_TOP], 1u);
            const unsigned tg = og / nx;
            if (og + 1u == (tg + 1u) * nx) xb_add(&bar[XB_TOPGEN], 1u);
            else XB_SPIN(xb_ld(&bar[XB_TOPGEN]) == tg, bar);
            __builtin_amdgcn_fence(__ATOMIC_ACQUIRE, "agent");
            xb_add(&bar[XB_XGEN(b.x)], 1u);
            asm volatile("s_waitcnt vmcnt(0)" ::: "memory");
        } else {
            XB_SPIN(xb_ld(&bar[XB_XGEN(b.x)]) == gen, bar);
            __builtin_amdgcn_fence(__ATOMIC_ACQUIRE, "agent");
            asm volatile("s_waitcnt vmcnt(0)" ::: "memory");
        }
    }
    __syncthreads();
}


struct Frame { LAS unsigned char* lds; int tid, lane, wave, vcu, G; };
struct Args { const float* in[25]; float* out; unsigned char* ws; int ph_lo, ph_hi, use_bar, pad; };
enum { I_XP = 0, I_XS, I_CCKV, I_CKR, I_CFK, I_CFV, I_CLOGF, I_CDK, I_CDV, I_GMIX, I_AWIN, I_AGQ, I_AWUQ, I_AGKV, I_AWUKV, I_ABF, I_AWOUT, I_CWIN, I_CLAM, I_CGSUB, I_CWOUT, I_GMLP, I_WUP, I_WDN, I_GFIN };

__device__ __forceinline__ float wave_sum(float v) {
#pragma unroll
    for (int o = 1; o < 64; o <<= 1) v += __shfl_xor(v, o);
    return v;
}
__device__ __forceinline__ int ain_src(int n) {
    if (n < 768) return n;
    if (n < 2304) return n + 32;
    if (n < 2336) return n - 2304 + 768;
    if (n < 2344) return n;
    return -1;
}
__device__ __forceinline__ void tr_item(const float* W, int ldw, int K, const float* gain, bf16* WT, int item, int nblk, bool ainmap, LAS float* scr, int lane) {
    const int kb = item / nblk, nb = item % nblk, k0 = 64 * kb, n0 = 32 * nb;
    const int n = n0 + (lane & 31); const int src = ainmap ? ain_src(n) : n;
#pragma unroll
    for (int i = 0; i < 32; ++i) { const int kk = 2 * i + (lane >> 5);
        float v = 0.f; if (src >= 0) { v = W[(size_t)(k0 + kk) * ldw + src]; if (gain) v *= gain[k0 + kk]; }
        scr[kk * 33 + (lane & 31)] = v; }
    LDS_WAIT(); asm volatile("" ::: "memory");
    const int c = lane & 7;
#pragma unroll
    for (int j = 0; j < 4; ++j) { const int nn = (lane >> 3) + 8 * j; const LAS float* s = scr + (8 * c) * 33 + nn;
        v4u o; o.x = pk2(s[0 * 33], s[1 * 33]); o.y = pk2(s[2 * 33], s[3 * 33]); o.z = pk2(s[4 * 33], s[5 * 33]); o.w = pk2(s[6 * 33], s[7 * 33]);
        *(GAS v4u*)(WT + (size_t)(n0 + nn) * K + k0 + 8 * c) = o; }
    LDS_WAIT(); asm volatile("" ::: "memory");
}
__device__ __forceinline__ void rope_entry(int pos, float chi, float clo, float& c, float& s) {
    const float p = (float)pos; const float t = p * chi; const float e = fmaf(p, chi, -t);
    float fr = t - rintf(t); fr += e + p * clo;
    c = __builtin_amdgcn_cosf(fr); s = __builtin_amdgcn_sinf(fr);
}

__device__ __forceinline__ void p0_prologue(const Frame& F, const Args& a) {
    unsigned char* ws = a.ws;
    LAS float* scr = (LAS float*)(F.lds + RING_OFF + F.wave * 16384);
    const int gw = F.vcu * NWAVES + F.wave, NGW = F.G * NWAVES;
    constexpr int I0 = 16 * 80, I1 = 8 * 24, I2 = 4 * 32, I3 = 16 * 32, I4 = 16 * 128, I5 = 64 * 32, I6 = 16 * 96, I7 = 16 * 32;
    constexpr int NITEMS = I0 + I1 + I2 + I3 + 2 * I4 + 2 * I5 + I6 + I7;
    for (int it = gw; it < NITEMS; it += NGW) {
        int r = it;
        if (r < I0) { tr_item(a.in[I_AWIN], A_IN, DM, a.in[I_GMIX], (bf16*)(ws + WS_WAIN), r, 80, true, scr, F.lane); continue; } r -= I0;
        if (r < I1) { tr_item(a.in[I_AWUQ], NQM, QLORA, a.in[I_AGQ], (bf16*)(ws + WS_WUQ), r, 24, false, scr, F.lane); continue; } r -= I1;
        if (r < I2) { tr_item(a.in[I_AWUKV], NKV, KVLORA, nullptr, (bf16*)(ws + WS_WUKV), r, 32, false, scr, F.lane); continue; } r -= I2;
        if (r < I3) { tr_item(a.in[I_AWOUT], DM, DM, nullptr, (bf16*)(ws + WS_WAOUT), r, 32, false, scr, F.lane); continue; } r -= I3;
        if (r < 2 * I4) { const int l = r / I4; tr_item(a.in[I_WUP] + (size_t)l * DM * DFF, DFF, DM, a.in[I_GMLP] + l * DM, (bf16*)(ws + WS_WUP) + (size_t)l * DFF * DM, r % I4, 128, false, scr, F.lane); continue; } r -= 2 * I4;
        if (r < 2 * I5) { const int l = r / I5; tr_item(a.in[I_WDN] + (size_t)l * DFF * DM, DM, DFF, nullptr, (bf16*)(ws + WS_WDN) + (size_t)l * DM * DFF, r % I5, 32, false, scr, F.lane); continue; } r -= 2 * I5;
        if (r < I6) { tr_item(a.in[I_CWIN], NC, DM, a.in[I_GMIX] + DM, (bf16*)(ws + WS_WCIN), r, 96, false, scr, F.lane); continue; } r -= I6;
        tr_item(a.in[I_CWOUT], DM, DM, nullptr, (bf16*)(ws + WS_WCOUT), r, 32, false, scr, F.lane);
    }
    { const int gt = F.vcu * (NWAVES * 64) + F.tid, NGT = F.G * NWAVES * 64;
      float* t16 = (float*)(ws + WS_TAB16); float* t8 = (float*)(ws + WS_TAB8);
      for (int e = gt; e < 8192 * 24; e += NGT) {
          float c, s;
          if (e < 8192 * 16) { const int pos = e >> 4, i = e & 15; rope_entry(pos, ROPE16_HI[i], ROPE16_LO[i], c, s); t16[pos * 32 + i] = c; t16[pos * 32 + 16 + i] = s; }
          else { const int e2 = e - 8192 * 16, pos = e2 >> 3, i = e2 & 7; rope_entry(pos, ROPE8_HI[i], ROPE8_LO[i], c, s); t8[pos * 16 + i] = c; t8[pos * 16 + 8 + i] = s; }
      } }
    { bf16* XB = (bf16*)(ws + WS_XB); float* SSQ = (float*)(ws + WS_SSQ);
      for (int m0 = gw; m0 < MT; m0 += 4 * NGW) {
          f32x4 v[4][4];
#pragma unroll
          for (int u = 0; u < 4; ++u) { const int m = m0 + u * NGW; if (m < MT) {
              const float* xrow = (m < MP) ? (a.in[I_XP] + (size_t)m * DM) : (a.in[I_XS] + (size_t)(m - MP) * DM);
              const GAS f32x4* xr = (const GAS f32x4*)xrow + F.lane;
#pragma unroll
              for (int j = 0; j < 4; ++j) v[u][j] = xr[64 * j]; } }
#pragma unroll
          for (int u = 0; u < 4; ++u) { const int m = m0 + u * NGW; if (m < MT) {
              float s = 0.f;
#pragma unroll
              for (int j = 0; j < 4; ++j) s += (v[u][j].x * v[u][j].x + v[u][j].y * v[u][j].y) + (v[u][j].z * v[u][j].z + v[u][j].w * v[u][j].w);
              s = wave_sum(s);
              GAS v2u* o8 = (GAS v2u*)(XB + (size_t)m * DM) + F.lane;
#pragma unroll
              for (int j = 0; j < 4; ++j) { v2u w; w.x = pk2(v[u][j].x, v[u][j].y); w.y = pk2(v[u][j].z, v[u][j].w); o8[64 * j] = w; }
              if (F.lane < 16) SSQ[(size_t)m * 16 + F.lane] = (F.lane == 0) ? s : 0.f; } }
      } }
    { const long gt = (long)F.vcu * (NWAVES * 64) + F.tid, NGT = (long)F.G * NWAVES * 64;
      bf16* CKVB = (bf16*)(ws + WS_R + R_CKVB); bf16* KRB = (bf16*)(ws + WS_R + R_KRB);
      constexpr long NC8 = (long)NBS * PAST * (KVLORA / 8), NK8 = (long)NBS * PAST * 4;
      for (long i0 = gt; i0 < NC8 + NK8; i0 += 4 * NGT) {
          f32x8 x[4];
#pragma unroll
          for (int u = 0; u < 4; ++u) { const long i = i0 + u * NGT; if (i < NC8 + NK8) {
              if (i < NC8) x[u] = *(const f32x8*)(a.in[I_CCKV] + (i >> 5) * KVLORA + (int)(i & 31) * 8);
              else { const long i2 = i - NC8; x[u] = *(const f32x8*)(a.in[I_CKR] + (i2 >> 2) * 32 + (int)(i2 & 3) * 8); } } }
#pragma unroll
          for (int u = 0; u < 4; ++u) { const long i = i0 + u * NGT; if (i < NC8 + NK8) {
              v4u w; w.x = pk2(x[u][0], x[u][1]); w.y = pk2(x[u][2], x[u][3]); w.z = pk2(x[u][4], x[u][5]); w.w = pk2(x[u][6], x[u][7]);
              if (i < NC8) { const long row = i >> 5; const int c = (int)(i & 31) * 8; const int b = (int)(row >> 12), j = (int)(row & 4095);
                  *(v4u*)(CKVB + ((size_t)MP + (size_t)b * KVL + j) * KVLORA + c) = w; }
              else { const long i2 = i - NC8; const long row = i2 >> 2; const int c = (int)(i2 & 3) * 8; const int b = (int)(row >> 12), j = (int)(row & 4095);
                  *(v4u*)(KRB + ((size_t)MP + (size_t)b * KVL + j) * 32 + c) = w; } } }
      } }
}

__device__ __forceinline__ void scan_seq(const Args& a, int q, int lane) {
    unsigned char* ws = a.ws; const float* out = a.out;
    const bool prm = q < 64; const int qq = prm ? q : q - 64; const int b = qq >> 3, h = qq & 7;
    const int len = prm ? SEQ : KVL, CH = prm ? 128 : 65;
    float* dst = prm ? ((float*)(ws + WS_R + R_CUMP) + (size_t)qq * SEQ) : ((float*)(ws + WS_R + R_CUMS) + (size_t)qq * KVL);
    const float* srcp = out + O_LOGF_P + (size_t)b * SEQ * 8 + h;
    const float* srcc = a.in[I_CLOGF] + (size_t)b * PAST * 8 + h;
    const float* srcn = out + O_LOGF_S + (size_t)b * DSEQ * 8 + h;
    double run = 0.0;
    for (int i = 0; i < CH; ++i) { const int t = lane * CH + i; if (t < len) { const float v = prm ? srcp[(size_t)t * 8] : (t < PAST ? srcc[(size_t)t * 8] : srcn[(size_t)(t - PAST) * 8]); run += (double)v; } }
    double incl = run;
#pragma unroll
    for (int o = 1; o < 64; o <<= 1) { const double t = __shfl_up(incl, o); if (lane >= o) incl += t; }
    run = incl - run;
    for (int i = 0; i < CH; ++i) { const int t = lane * CH + i; if (t < len) { const float v = prm ? srcp[(size_t)t * 8] : (t < PAST ? srcc[(size_t)t * 8] : srcn[(size_t)(t - PAST) * 8]); run += (double)v; dst[t] = (float)(-run * 1.4426950408889634); } }
}

__device__ __forceinline__ float diff_lambda(const float* lamp, int lane) {
    const float s1 = wave_sum(lamp[lane] * lamp[64 + lane]), s2 = wave_sum(lamp[128 + lane] * lamp[192 + lane]);
    return __expf(s1) - __expf(s2) + LAM_INIT;
}

__device__ __forceinline__ att::f32x16 mini_acc(const bf16* A, int lda, const bf16* W, int ldw, int kbeg, int kend, int lane) {
    const int r32 = lane & 31, hi = lane >> 5;
    const bf16* ap = A + (size_t)r32 * lda + hi * 8; const bf16* wp = W + (size_t)r32 * ldw + hi * 8;
    att::f32x16 acc = {};
    for (int k = kbeg; k < kend; k += 128) {
        bf16x8 a[8], b[8];
#pragma unroll
        for (int i = 0; i < 8; ++i) { a[i] = *reinterpret_cast<const bf16x8*>(ap + k + 16 * i); b[i] = *reinterpret_cast<const bf16x8*>(wp + k + 16 * i); }
#pragma unroll
        for (int i = 0; i < 8; ++i) acc = __builtin_amdgcn_mfma_f32_32x32x16_bf16(a[i], b[i], acc, 0, 0, 0);
    }
    return acc;
}
__device__ __forceinline__ void mini_res(const Frame& F, const bf16* A  , int K, const bf16* Wt, const float* base  , float* X, bf16* XB, float* SSQ) {
    LAS float* red = (LAS float*)(F.lds + RING_OFF);
    const int r32 = F.lane & 31, hi = F.lane >> 5, cb = F.wave & 1, kq = F.wave >> 1;
    for (int t = F.vcu; t < 256; t += F.G) {
        const int rg = t & 15, cg = t >> 4;
        const att::f32x16 acc = mini_acc(A + (size_t)rg * 32 * K, K, Wt + (size_t)(cg * 64 + cb * 32) * K, K, kq * (K / 4), (kq + 1) * (K / 4), F.lane);
#pragma unroll
        for (int r = 0; r < 16; ++r) red[(kq * 32 + att::crow(r, hi)) * 64 + cb * 32 + r32] = acc[r];
        __syncthreads();
        { const int row = F.tid >> 4, c4 = (F.tid & 15) * 4; const size_t grow = (size_t)MP + rg * 32 + row; const size_t off = ((size_t)rg * 32 + row) * DM + cg * 64 + c4;
          f32x4 x = *(const f32x4*)(base + off);
#pragma unroll
          for (int q = 0; q < 4; ++q) x += *(const LAS f32x4*)(red + (q * 32 + row) * 64 + c4);
          *(f32x4*)(X + grow * DM + cg * 64 + c4) = x; v2u w; w.x = pk2(x.x, x.y); w.y = pk2(x.z, x.w); *(v2u*)(XB + grow * DM + cg * 64 + c4) = w;
          float ss = (x.x * x.x + x.y * x.y) + (x.z * x.z + x.w * x.w);
          ss += __shfl_xor(ss, 1); ss += __shfl_xor(ss, 2); ss += __shfl_xor(ss, 4); ss += __shfl_xor(ss, 8);
          if ((F.tid & 15) == 0) SSQ[grow * 16 + cg] = ss; }
        __syncthreads();
    }
}
__device__ __forceinline__ void mini_up(const Frame& F, const bf16* XBs  , const bf16* Wt, const float* SSQ, bf16* U) {
    LAS float* rsl = (LAS float*)(F.lds + RING_OFF);
    const int r32 = F.lane & 31, hi = F.lane >> 5;
    for (int t = F.vcu; t < 256; t += F.G) {
        const int rg = t & 15, cg = t >> 4;
        if (F.tid < 32) { const float* p = SSQ + ((size_t)MP + rg * 32 + F.tid) * 16; float s = 0.f;
#pragma unroll
            for (int q = 0; q < 4; ++q) { const f32x4 v = *(const f32x4*)(p + 4 * q); s += (v.x + v.y) + (v.z + v.w); }
            rsl[F.tid] = rsqrtf(s * (1.0f / 1024.0f) + 1e-6f); }
        const att::f32x16 acc = mini_acc(XBs + (size_t)rg * 32 * DM, DM, Wt + (size_t)(cg * 256 + F.wave * 32) * DM, DM, 0, DM, F.lane);
        __syncthreads();
#pragma unroll
        for (int r = 0; r < 16; ++r) { const int row = att::crow(r, hi); const float v = fmaxf(acc[r] * rsl[row], 0.f);
            U[((size_t)MP + rg * 32 + row) * DFF + cg * 256 + F.wave * 32 + r32] = (bf16)(pk2(v * v, 0.f) & 0xffffu); }
        __syncthreads();
    }
}

constexpr int N_PHASES = 15;
#ifndef MK_PER_PHASE
#define MK_PER_PHASE 0
#endif
#ifndef MK_PH_END
#define MK_PH_END N_PHASES
#endif

__global__ void __launch_bounds__(NWAVES * 64, 2) mk_fwd(Args args) {
    extern __shared__ __attribute__((aligned(16))) unsigned char lds[];
    Frame F;
    F.lds = (LAS unsigned char*)lds;
    F.tid = threadIdx.x; F.lane = F.tid & 63; F.wave = __builtin_amdgcn_readfirstlane(F.tid >> 6);
    F.G = gridDim.x; { const int bx = blockIdx.x; F.vcu = (F.G % 8 == 0) ? (bx % 8) * (F.G / 8) + bx / 8 : bx; }
    unsigned char* ws = args.ws; float* out = args.out;
    gu32* ctl = (gu32*)(ws + WS_CTL);
    for (int u = F.tid; u < (LDS_BYTES - LDSCTL_OFF) / 4; u += NWAVES * 64) ((LAS unsigned*)(F.lds + LDSCTL_OFF))[u] = 0u;
    __syncthreads();
    volatile LAS unsigned* MISC = (volatile LAS unsigned*)(F.lds + LDSCTL_OFF);
    XcdBarrier bar; bar.bar = (unsigned*)(ctl + CW_BAR); bar.x = 0; bar.st = nullptr;
    if (args.use_bar) bar = xcd_barrier_post((unsigned*)(ctl + CW_BAR), MISC);
    const int lo = args.ph_lo, hi = args.ph_hi;
#ifndef MK_ONLY
#define MK_ONLY -1
#endif
#define IN(k) ((MK_ONLY < 0 || MK_ONLY == (k)) && lo <= (k) && (k) < hi)
#ifndef MK_SUB
#define MK_SUB 0xff
#endif
#define SUB(bit) (((MK_SUB >> (bit)) & 1) && (((args.pad >> 8) & 0xff) == 0 || ((args.pad >> (8 + (bit))) & 1)))
#define SEAM(k) do { if (IN(k) && IN((k) + 1)) xcd_barrier(bar); } while (0)

    bf16* XB = (bf16*)(ws + WS_XB); float* SSQ = (float*)(ws + WS_SSQ); float* X = out + O_Y;
    float* Xw = args.pad ? (float*)(ws + WS_R + R_ENDU) : X; bf16* XBw = args.pad ? (bf16*)(ws + WS_R + R_ENDU + (size_t)MT * DM * 4) : XB; float* SSQw = args.pad ? (float*)(ws + WS_R + R_ENDU + (size_t)MT * DM * 6) : SSQ;
    unsigned char* R = ws + WS_R;
    bf16* OB = (bf16*)(R + R_O);
    const float* TAB16 = (const float*)(ws + WS_TAB16); const float* TAB8 = (const float*)(ws + WS_TAB8);
    const int gw = F.vcu * NWAVES + F.wave, NGW = F.G * NWAVES;

    if (IN(0)) { p0_prologue(F, args); } SEAM(0);

    if (IN(1)) {
        pg8::Gemm g{XB, (const bf16*)(ws + WS_WAIN), MT, NA, DM}; pg8::StaticOrder S; S.init(MT, NA, F.G, (int)blockIdx.x);
        pg8::EpiAin E{SSQ, (bf16*)(R + R_QLAT), (float*)(R + R_QSSQ), (bf16*)(R + R_CKVB), (bf16*)(R + R_KRB), (bf16*)(R + R_FQ), (bf16*)(R + R_FK), (bf16*)(R + R_FV),
                      out, args.in[I_AGKV], args.in[I_ABF], TAB16, (LAS float*)(F.lds + EX_OFF), (LAS unsigned*)(F.lds + LDSCTL_OFF + 16)};
        pg8::gemm_phase<pg8::EpiAin, pg8::StaticOrder, true, true>(F.lds + RING_OFF, g, S, E);
    } SEAM(1);

    if (IN(2)) {
        if (SUB(0) && F.wave == 0) for (int q = F.vcu; q < 192; q += F.G) scan_seq(args, q, F.lane);
        if (SUB(1)) { pg8::Gemm g{(const bf16*)(R + R_QLAT), (const bf16*)(ws + WS_WUQ), MT, NQM, QLORA}; pg8::StaticOrder S; S.init(MT, NQM, F.G, (int)blockIdx.x);
          pg8::EpiQup E{(bf16*)(R + R_QM), (const float*)(R + R_QSSQ), TAB16};
          pg8::gemm_phase<pg8::EpiQup, pg8::StaticOrder, true, true>(F.lds + RING_OFF, g, S, E); }
        if (SUB(2)) { int kk = KVLORA; asm volatile("" : "+s"(kk));
          pg8::Gemm g{(const bf16*)(R + R_CKVB), (const bf16*)(ws + WS_WUKV), MKV, NKV, kk}; pg8::StaticOrder S; S.init(MKV, NKV, F.G, (int)blockIdx.x);
          pg8::EpiKv E{(bf16*)(R + R_KV), NKV};
          pg8::gemm_phase<pg8::EpiKv, pg8::StaticOrder, true, true>(F.lds + RING_OFF, g, S, E); }
    } SEAM(2);

    if (IN(3)) {
        const bf16* QM = (const bf16*)(R + R_QM); const bf16* KV = (const bf16*)(R + R_KV); const bf16* KRB = (const bf16*)(R + R_KRB);
        const bf16* FQ = (const bf16*)(R + R_FQ); const bf16* FK = (const bf16*)(R + R_FK); const bf16* FV = (const bf16*)(R + R_FV);
        const float* CUMP = (const float*)(R + R_CUMP); const float* CUMS = (const float*)(R + R_CUMS);
        if (SUB(0)) for (int set = F.vcu; set < 512; set += F.G) {
            const int bh = set >> 3, s = set & 7, b = bh >> 3, h = bh & 7; const size_t r0 = (size_t)b * SEQ;
            att::ASrc A{QM + r0 * NQM + h * 96, NQM, KV + r0 * NKV + h * 128, NKV, KRB + r0 * 32, 32, KV + r0 * NKV + h * 128 + 64, NKV, nullptr};
            for (int i = 0; i < 4; ++i) { const int qb = (i == 0) ? s : (i == 1) ? 15 - s : (i == 2) ? 16 + s : 31 - s;
                att::f32x16 o[2]; att::attn_unit<0>(A, qb, (char*)lds + RING_OFF, o);
                att::store_o_bf16<64>(o, (char*)lds + RING_OFF + att::ALds<0>::L_OST, OB + (r0 + (size_t)qb * 256 + F.wave * 32) * DM + h * 64, DM); }
        }
        if (SUB(1)) for (int set = F.vcu; set < 512; set += F.G) {
            const int bh = set >> 3, s = set & 7, b = bh >> 3, h = bh & 7; const size_t r0 = (size_t)b * SEQ;
            att::ASrc A{FQ + r0 * 512 + h * 64, 512, FK + r0 * 512 + h * 64, 512, nullptr, 0, FV + r0 * 512 + h * 64, 512, CUMP + (size_t)bh * SEQ};
            for (int i = 0; i < 4; ++i) { const int qb = (i == 0) ? s : (i == 1) ? 15 - s : (i == 2) ? 16 + s : 31 - s;
                att::f32x16 o[2]; att::attn_unit<1>(A, qb, (char*)lds + RING_OFF, o);
                att::store_o_bf16<64>(o, (char*)lds + RING_OFF + att::ALds<1>::L_OST, OB + (r0 + (size_t)qb * 256 + F.wave * 32) * DM + 512 + h * 64, DM); }
        }
        char* wl = (char*)lds + RING_OFF + F.wave * 16384; float* wscr = (float*)((char*)lds + SAMP_SCR_OFF) + F.wave * 64;
        if (SUB(2)) for (int u = gw; u < 128 * NSPLIT; u += NGW) {
            const int bh = u / NSPLIT, sp = u % NSPLIT, b = bh >> 3, h = bh & 7; const size_t rq = (size_t)MP + (size_t)b * DSEQ, rk = (size_t)MP + (size_t)b * KVL;
            att::SSrc Sx{QM + rq * NQM + h * 96, NQM, KV + rk * NKV + h * 128, NKV, KRB + rk * 32, 32, KV + rk * NKV + h * 128 + 64, NKV, nullptr, nullptr, 0, nullptr, nullptr, 0, nullptr};
            att::sample_unit<0>(Sx, sp, wl, wscr, (float*)(R + R_PARTM) + (size_t)u * (32 * 66)); }
        if (SUB(3)) for (int u = gw; u < 128 * NSPLIT; u += NGW) {
            const int bh = u / NSPLIT, sp = u % NSPLIT, b = bh >> 3, h = bh & 7; const size_t rq = (size_t)MP + (size_t)b * DSEQ;
            att::SSrc Sx{FQ + rq * 512 + h * 64, 512, nullptr, 0, nullptr, 0, nullptr, 0,
                         args.in[I_CFK] + ((size_t)b * PAST * 8 + h) * 64, out + O_FK_S + ((size_t)b * DSEQ * 8 + h) * 64, 512,
                         args.in[I_CFV] + ((size_t)b * PAST * 8 + h) * 64, out + O_FV_S + ((size_t)b * DSEQ * 8 + h) * 64, 512, CUMS + (size_t)bh * KVL};
            att::sample_unit<1>(Sx, sp, wl, wscr, (float*)(R + R_PARTF) + (size_t)u * (32 * 66)); }
    } SEAM(3);

    if (IN(4)) {
        const int gt = F.vcu * (NWAVES * 64) + F.tid, NGT = F.G * NWAVES * 64;
        for (int it = gt; it < 2 * 128 * 32 * 8; it += NGT) {
            const int ty = it >> 15, r = it & 32767, bh = r >> 8, row = (r >> 3) & 31, ch = r & 7, b = bh >> 3, h = bh & 7;
            const float* P = (const float*)(R + (ty ? R_PARTF : R_PARTM)) + (size_t)bh * NSPLIT * (32 * 66);
            float mmax = -INFINITY;
#pragma unroll
            for (int s = 0; s < NSPLIT; ++s) mmax = fmaxf(mmax, P[s * (32 * 66) + 32 * 64 + row]);
            float L = 0.f; float acc[8] = {0.f, 0.f, 0.f, 0.f, 0.f, 0.f, 0.f, 0.f};
#pragma unroll
            for (int s = 0; s < NSPLIT; ++s) { const float* Ps = P + s * (32 * 66); const float w = __builtin_amdgcn_exp2f(Ps[32 * 64 + row] - mmax); L += Ps[32 * 64 + 32 + row] * w;
                const f32x8 ov = *(const f32x8*)(Ps + row * 64 + ch * 8);
#pragma unroll
                for (int j = 0; j < 8; ++j) acc[j] += ov[j] * w; }
            const float rl = 1.0f / L;
            v4u w4; w4.x = pk2(acc[0] * rl, acc[1] * rl); w4.y = pk2(acc[2] * rl, acc[3] * rl); w4.z = pk2(acc[4] * rl, acc[5] * rl); w4.w = pk2(acc[6] * rl, acc[7] * rl);
            *(v4u*)(OB + ((size_t)MP + (size_t)b * DSEQ + row) * DM + ty * 512 + h * 64 + ch * 8) = w4;
        }
    } SEAM(4);

    if (IN(5)) {
        pg8::Gemm g{OB, (const bf16*)(ws + WS_WAOUT), MP, DM, DM}; pg8::StaticOrder S; S.init(MP, DM, F.G, (int)blockIdx.x);
        pg8::EpiRes E{args.in[I_XP], args.in[I_XS], Xw, XBw, SSQw};
        pg8::gemm_phase<pg8::EpiRes, pg8::StaticOrder, true, true>(F.lds + RING_OFF, g, S, E);
        mini_res(F, OB + (size_t)MP * DM, DM, (const bf16*)(ws + WS_WAOUT), args.in[I_XS], Xw, XBw, SSQw);
    } SEAM(5);
    if (IN(6)) {
        pg8::Gemm g{XB, (const bf16*)(ws + WS_WUP), MP, DFF, DM}; pg8::StaticOrder S; S.init(MP, DFF, F.G, (int)blockIdx.x);
        pg8::EpiUp E{(bf16*)(R + R_U), SSQ};
        pg8::gemm_phase<pg8::EpiUp, pg8::StaticOrder, true, true>(F.lds + RING_OFF, g, S, E);
        mini_up(F, XB + (size_t)MP * DM, (const bf16*)(ws + WS_WUP), SSQ, (bf16*)(R + R_U));
    } SEAM(6);
    if (IN(7)) {
        pg8::Gemm g{(const bf16*)(R + R_U), (const bf16*)(ws + WS_WDN), MP, DM, DFF}; pg8::StaticOrder S; S.init(MP, DM, F.G, (int)blockIdx.x);
        pg8::EpiRes E{X, X + (size_t)MP * DM, Xw, XBw, SSQw};
        pg8::gemm_phase<pg8::EpiRes, pg8::StaticOrder, true, true>(F.lds + RING_OFF, g, S, E);
        mini_res(F, (const bf16*)(R + R_U) + (size_t)MP * DFF, DFF, (const bf16*)(ws + WS_WDN), X + (size_t)MP * DM, Xw, XBw, SSQw);
    } SEAM(7);

    if (IN(8)) {
        pg8::Gemm g{XB, (const bf16*)(ws + WS_WCIN), MT, NC, DM}; pg8::StaticOrder S; S.init(MT, NC, F.G, (int)blockIdx.x);
        pg8::EpiCin E{SSQ, (bf16*)(R + R_QC), out, TAB8};
        pg8::gemm_phase<pg8::EpiCin, pg8::StaticOrder, true, true>(F.lds + RING_OFF, g, S, E);
    } SEAM(8);

    if (IN(9)) {
        const bf16* QC = (const bf16*)(R + R_QC); const bf16* KC = (const bf16*)(R + R_KC); const bf16* VC = (const bf16*)(R + R_VC);
        const float lam = diff_lambda(args.in[I_CLAM], F.lane);
        const int r32 = F.lane & 31, hi = F.lane >> 5;
        volatile float* S1 = (volatile float*)(R + R_S1) + ((size_t)blockIdx.x * NWAVES + F.wave) * 4096 + F.lane;
        if (SUB(0)) for (int set = F.vcu; set < 512; set += F.G) {
            const int bh = set >> 3, s = set & 7, b = bh >> 3, h = bh & 7; const size_t r0 = (size_t)b * SEQ;
            for (int i = 0; i < 4; ++i) { const int qb = (i == 0) ? s : (i == 1) ? 15 - s : (i == 2) ? 16 + s : 31 - s;
                att::f32x16 o[4];
#pragma unroll 1
                for (int mp = 0; mp < 2; ++mp) {
                    att::ASrc A{QC + r0 * DM + h * 128 + mp * 64, DM, KC + r0 * DM + h * 128 + mp * 64, DM, nullptr, 0, VC + r0 * DM + h * 128, DM, nullptr};
                    att::attn_unit<2>(A, qb, (char*)lds + RING_OFF, o);
                    if (mp == 0) {
#pragma unroll
                        for (int d = 0; d < 4; ++d) { volatile float* Sd = S1 + d * 1024; asm volatile("" : "+v"(Sd));
#pragma unroll
                            for (int r = 0; r < 16; ++r) Sd[r * 64] = o[d][r]; }
                    }
                }
                VM_WAIT();
                float ss[16];
#pragma unroll
                for (int r = 0; r < 16; ++r) ss[r] = 0.f;
#pragma unroll
                for (int d = 0; d < 4; ++d) { volatile float* Sd = S1 + d * 1024; asm volatile("" : "+v"(Sd));
#pragma unroll
                    for (int r = 0; r < 16; ++r) { const float v = Sd[r * 64] - lam * o[d][r]; o[d][r] = v; ss[r] += v * v; }
                    asm volatile("" ::: "memory"); }
#pragma unroll
                for (int r = 0; r < 16; ++r) { float t = ss[r]; t += __shfl_xor(t, 1); t += __shfl_xor(t, 2); t += __shfl_xor(t, 4); t += __shfl_xor(t, 8); t += __shfl_xor(t, 16);
                    ss[r] = rsqrtf(t * (1.0f / 128.0f) + 1e-5f) * ONE_M_LAM_INIT; }
#pragma unroll
                for (int d = 0; d < 4; ++d) { const float gs = args.in[I_CGSUB][d * 32 + r32];
#pragma unroll
                    for (int r = 0; r < 16; ++r) o[d][r] *= ss[r] * gs; }
                att::store_o_bf16<128>(o, (char*)lds + RING_OFF + att::ALds<2>::L_OST, OB + (r0 + (size_t)qb * 256 + F.wave * 32) * DM + h * 128, DM);
            }
        }
        char* wl = (char*)lds + RING_OFF + F.wave * 16384; float* wscr = (float*)((char*)lds + SAMP_SCR_OFF) + F.wave * 64;
        if (SUB(2)) for (int u = gw; u < 2 * 128 * NSPLIT; u += NGW) {
            const int mp = u / (128 * NSPLIT), u2 = u % (128 * NSPLIT), bh = u2 / NSPLIT, sp = u2 % NSPLIT, b = bh >> 3, h = bh & 7; const size_t rq = (size_t)MP + (size_t)b * DSEQ;
            att::SSrc Sx{QC + rq * DM + h * 128 + mp * 64, DM, nullptr, 0, nullptr, 0, nullptr, 0,
                         args.in[I_CDK] + ((size_t)b * PAST * 8 + h) * 128 + mp * 64, out + O_DK_S + ((size_t)b * DSEQ * 8 + h) * 128 + mp * 64, 1024,
                         args.in[I_CDV] + ((size_t)b * PAST * 8 + h) * 128, out + O_DV_S + ((size_t)b * DSEQ * 8 + h) * 128, 1024, nullptr};
            att::sample_unit<2>(Sx, sp, wl, wscr, (float*)(R + R_PARTD) + (size_t)u * (32 * 130)); }
        (void)hi;
    } SEAM(9);

    if (IN(10)) {
        const float lam = diff_lambda(args.in[I_CLAM], F.lane);
        const int gt = F.vcu * (NWAVES * 64) + F.tid, NGT = F.G * NWAVES * 64;
        for (int it = gt; it < 128 * 32 * 16; it += NGT) {
            const int bh = it >> 9, row = (it >> 4) & 31, ch = it & 15, b = bh >> 3, h = bh & 7;
            float res[2][8];
#pragma unroll
            for (int mp = 0; mp < 2; ++mp) {
                const float* P = (const float*)(R + R_PARTD) + ((size_t)mp * 128 * NSPLIT + (size_t)bh * NSPLIT) * (32 * 130);
                float mmax = -INFINITY;
#pragma unroll 4
                for (int s = 0; s < NSPLIT; ++s) mmax = fmaxf(mmax, P[s * (32 * 130) + 32 * 128 + row]);
                float L = 0.f; float acc[8] = {0.f, 0.f, 0.f, 0.f, 0.f, 0.f, 0.f, 0.f};
#pragma unroll 2
                for (int s = 0; s < NSPLIT; ++s) { const float* Ps = P + s * (32 * 130); const float w = __builtin_amdgcn_exp2f(Ps[32 * 128 + row] - mmax); L += Ps[32 * 128 + 32 + row] * w;
                    const f32x8 ov = *(const f32x8*)(Ps + row * 128 + ch * 8);
#pragma unroll
                    for (int j = 0; j < 8; ++j) acc[j] += ov[j] * w; }
                const float rl = 1.0f / L;
#pragma unroll
                for (int j = 0; j < 8; ++j) res[mp][j] = acc[j] * rl;
            }
            float v[8]; float ss = 0.f;
#pragma unroll
            for (int j = 0; j < 8; ++j) { v[j] = res[0][j] - lam * res[1][j]; ss += v[j] * v[j]; }
            ss += __shfl_xor(ss, 1); ss += __shfl_xor(ss, 2); ss += __shfl_xor(ss, 4); ss += __shfl_xor(ss, 8);
            const float rs = rsqrtf(ss * (1.0f / 128.0f) + 1e-5f) * ONE_M_LAM_INIT;
            const f32x8 gs = *(const f32x8*)(args.in[I_CGSUB] + ch * 8);
            v4u w4; w4.x = pk2(v[0] * rs * gs[0], v[1] * rs * gs[1]); w4.y = pk2(v[2] * rs * gs[2], v[3] * rs * gs[3]); w4.z = pk2(v[4] * rs * gs[4], v[5] * rs * gs[5]); w4.w = pk2(v[6] * rs * gs[6], v[7] * rs * gs[7]);
            *(v4u*)(OB + ((size_t)MP + (size_t)b * DSEQ + row) * DM + h * 128 + ch * 8) = w4;
        }
    } SEAM(10);

    if (IN(11)) {
        pg8::Gemm g{OB, (const bf16*)(ws + WS_WCOUT), MP, DM, DM}; pg8::StaticOrder S; S.init(MP, DM, F.G, (int)blockIdx.x);
        pg8::EpiRes E{X, X + (size_t)MP * DM, Xw, XBw, SSQw};
        pg8::gemm_phase<pg8::EpiRes, pg8::StaticOrder, true, true>(F.lds + RING_OFF, g, S, E);
        mini_res(F, OB + (size_t)MP * DM, DM, (const bf16*)(ws + WS_WCOUT), X + (size_t)MP * DM, Xw, XBw, SSQw);
    } SEAM(11);
    if (IN(12)) {
        pg8::Gemm g{XB, (const bf16*)(ws + WS_WUP) + (size_t)DFF * DM, MP, DFF, DM}; pg8::StaticOrder S; S.init(MP, DFF, F.G, (int)blockIdx.x);
        pg8::EpiUp E{(bf16*)(R + R_U), SSQ};
        pg8::gemm_phase<pg8::EpiUp, pg8::StaticOrder, true, true>(F.lds + RING_OFF, g, S, E);
        mini_up(F, XB + (size_t)MP * DM, (const bf16*)(ws + WS_WUP) + (size_t)DFF * DM, SSQ, (bf16*)(R + R_U));
    } SEAM(12);
    if (IN(13)) {
        pg8::Gemm g{(const bf16*)(R + R_U), (const bf16*)(ws + WS_WDN) + (size_t)DM * DFF, MP, DM, DFF}; pg8::StaticOrder S; S.init(MP, DM, F.G, (int)blockIdx.x);
        pg8::EpiRes E{X, X + (size_t)MP * DM, Xw, XBw, SSQw};
        pg8::gemm_phase<pg8::EpiRes, pg8::StaticOrder, true, true>(F.lds + RING_OFF, g, S, E);
        mini_res(F, (const bf16*)(R + R_U) + (size_t)MP * DFF, DFF, (const bf16*)(ws + WS_WDN) + (size_t)DM * DFF, X + (size_t)MP * DM, Xw, XBw, SSQw);
    } SEAM(13);

    if (IN(14)) {
        const float* gf = args.in[I_GFIN];
        for (int m0 = gw; m0 < MT; m0 += 2 * NGW) {
            f32x4 xv[2][4], pvv[2];
#pragma unroll
            for (int u = 0; u < 2; ++u) { const int m = m0 + u * NGW; if (m < MT) {
                pvv[u] = *(const f32x4*)(SSQ + (size_t)m * 16 + 4 * (F.lane & 3));
                const GAS f32x4* xr = (const GAS f32x4*)(X + (size_t)m * DM) + F.lane;
#pragma unroll
                for (int j = 0; j < 4; ++j) xv[u][j] = xr[64 * j]; } }
#pragma unroll
            for (int u = 0; u < 2; ++u) { const int m = m0 + u * NGW; if (m < MT) {
                float s = (pvv[u].x + pvv[u].y) + (pvv[u].z + pvv[u].w); s += __shfl_xor(s, 1); s += __shfl_xor(s, 2);
                const float rs = rsqrtf(s * (1.0f / 1024.0f) + 1e-6f);
                const GAS f32x4* gr = (const GAS f32x4*)gf + F.lane; GAS f32x4* yr = (GAS f32x4*)(Xw + (size_t)m * DM) + F.lane;
#pragma unroll
                for (int j = 0; j < 4; ++j) yr[64 * j] = xv[u][j] * rs * gr[64 * j]; } }
        }
    }
#undef IN
#undef SEAM
}


#ifdef MK_PROBE
__global__ void probe_scale(float* out, unsigned mask) {
    const size_t offs[17] = {0, 67108864, O_CKV_P, O_KROPE_P, O_FK_P, O_FV_P, O_LOGF_P, O_DK_P, O_DV_P, O_CKV_S, O_KROPE_S, O_FK_S, O_FV_S, O_LOGF_S, O_DK_S, O_DV_S, O_END};
    for (int t = 0; t < 16; ++t) {
        const bool on = (mask >> t) & 1u;
        for (size_t i = offs[t] + (size_t)blockIdx.x * 256 + threadIdx.x; i < offs[t + 1]; i += (size_t)gridDim.x * 256) out[i] = on ? out[i] * 2.f : 0.f;
    }
}
#endif
extern "C" void kernel_launch(void* const* d_in, const int* in_sizes, int n_in, void* d_out, int out_size, void* d_ws, size_t ws_size, hipStream_t stream) {
    static int grid = 0;
    if (grid == 0) {
        if (n_in != 25 || in_sizes[0] != MP * DM || (size_t)out_size != O_END || ws_size < WS_END) {
            fprintf(stderr, "kernel_launch: shape mismatch: n_in %d in0 %d out %d ws %zu (need %zu)\n", n_in, n_in > 0 ? in_sizes[0] : -1, out_size, ws_size, (size_t)WS_END); grid = -1; return; }
        int dev = 0, cus = 0;
        if (hipGetDevice(&dev) != hipSuccess || hipDeviceGetAttribute(&cus, hipDeviceAttributeMultiprocessorCount, dev) != hipSuccess) { grid = -1; return; }
        if (hipFuncSetAttribute((const void*)mk_fwd, hipFuncAttributeMaxDynamicSharedMemorySize, LDS_BYTES) != hipSuccess) { fprintf(stderr, "kernel_launch: hipFuncSetAttribute failed\n"); grid = -1; return; }
        int per_cu = 0;
        if (hipOccupancyMaxActiveBlocksPerMultiprocessor(&per_cu, (const void*)mk_fwd, NWAVES * 64, LDS_BYTES) != hipSuccess || per_cu < 1)
            fprintf(stderr, "kernel_launch: occupancy query reports %d workgroups per CU\n", per_cu);
        (void)hipGetLastError();
        grid = cus;
    }
    if (grid < 0) return;
    if (hipMemsetAsync((char*)d_ws + WS_CTL, 0, CTL_BYTES, stream) != hipSuccess) return;
    Args a{};
    for (int i = 0; i < 25; ++i) a.in[i] = (const float*)d_in[i];
    a.out = (float*)d_out; a.ws = (unsigned char*)d_ws;
#if MK_PER_PHASE
#ifndef MK_REP
#define MK_REP 0
#endif
#ifndef MK_DRY
#define MK_DRY 0
#endif
    for (int p = 0; p < MK_PH_END; ++p) {
        if ((MK_DRY >> p) & 1) { a.ph_lo = p; a.ph_hi = p + 1; a.use_bar = 0; a.pad = 1; hipLaunchKernelGGL(mk_fwd, dim3(grid), dim3(NWAVES * 64), LDS_BYTES, stream, a); a.pad = 0; }
#ifndef MK_REPSUB
#define MK_REPSUB 0
#endif
        for (int rep = 0; rep < 1 + ((MK_REP >> p) & 1); ++rep) { a.ph_lo = p; a.ph_hi = p + 1; a.use_bar = 0; a.pad = rep ? (MK_REPSUB << 8) : 0; hipLaunchKernelGGL(mk_fwd, dim3(grid), dim3(NWAVES * 64), LDS_BYTES, stream, a); a.pad = 0; } }
#else
    a.ph_lo = 0; a.ph_hi = MK_PH_END; a.use_bar = 1;
    hipLaunchKernelGGL(mk_fwd, dim3(grid), dim3(NWAVES * 64), LDS_BYTES, stream, a);
#endif
#ifdef MK_PROBE
    hipLaunchKernelGGL(probe_scale, dim3(2048), dim3(256), 0, stream, (float*)d_out, (unsigned)MK_PROBE);
#endif
    const hipError_t le = hipPeekAtLastError();
    if (le != hipSuccess) fprintf(stderr, "kernel_launch: launch failed: %s\n", hipGetErrorName(le));
}
```
